# Optimizing an MI355X kernel written in HIP

```python
import jax, jax.numpy as jnp
from jax import lax
import numpy as np

D_MODEL = 2048
BATCH = 2
SEQ = 16384
DEPTH = 1

NORM_EPS = 1e-5
RWKV_WIDTH = D_MODEL // 2
RWKV_HEAD = 64
RWKV_HEADS = RWKV_WIDTH // RWKV_HEAD
DECAY_LORA = 64
ICLR_LORA = 64
GATE_LORA = 128
LNX_EPS = 64e-5
HEAD_DIM = 64
ATTN_HEADS = (D_MODEL // 2) // HEAD_DIM
KV_HEADS = 4
GROUP = ATTN_HEADS // KV_HEADS
WINDOW = 128
N_EXPERTS = 32
TOP_K = 4
D_FF = D_MODEL
SWIGLU_LIMIT = 7.0
SWIGLU_ALPHA = 1.702
MOE_BLOCK = 512
RWKV_SPLITS = (RWKV_WIDTH, RWKV_WIDTH, RWKV_WIDTH, DECAY_LORA, ICLR_LORA, GATE_LORA)
RWKV_COLS = sum(RWKV_SPLITS)
QKV_SPLITS = (ATTN_HEADS * HEAD_DIM, KV_HEADS * HEAD_DIM, KV_HEADS * HEAD_DIM)
QKV_COLS = sum(QKV_SPLITS)
IN_COLS = RWKV_COLS + QKV_COLS + 2 * D_MODEL

kernel_name = 'hybrid_rwkv7_swa_sink_moe'


def _split(t, sizes):
    idx = tuple(int(i) for i in np.cumsum(sizes)[:-1])
    return jnp.split(t, idx, axis=-1)


def rms_norm(x, g):
    xf = x.astype(jnp.float32)
    y = xf * lax.rsqrt(jnp.mean(xf * xf, axis=-1, keepdims=True) + NORM_EPS)
    return (y * g.astype(jnp.float32)).astype(x.dtype)


def token_shift(t):
    return jnp.pad(t[:, :-1], ((0, 0), (1, 0), (0, 0)))


def wkv7_scan(r, w, k, v, a, b):
    B, S, H, N = r.shape
    def step(state, inp):
        r_t, w_t, k_t, v_t, a_t, b_t = inp
        sa = jnp.einsum('bhij,bhj->bhi', state, a_t)
        state = state * w_t[:, :, None, :] + sa[..., None] * b_t[:, :, None, :] + v_t[..., None] * k_t[:, :, None, :]
        return state, jnp.einsum('bhij,bhj->bhi', state, r_t)
    s0 = jnp.zeros((B, H, N, N), jnp.float32)
    seq_major = tuple(jnp.moveaxis(t, 1, 0) for t in (r, w, k, v, a, b))
    _, y = lax.scan(step, s0, seq_major)
    return jnp.moveaxis(y, 0, 1)


def rwkv7_time_mix(r, k, v, zw, za, zg, w0, w_decay_up, a0, w_iclr_up, w_gate_up, k_k, k_a, r_k, lnx_g, lnx_b):
    B, S, C = r.shape
    f32 = jnp.float32
    heads = lambda t: t.astype(f32).reshape(B, S, RWKV_HEADS, RWKV_HEAD)
    w_log = -jax.nn.softplus(-(w0 + jnp.tanh(zw) @ w_decay_up).astype(f32)) - 0.5
    decay = jnp.exp(-jnp.exp(w_log))
    a = jax.nn.sigmoid((a0 + za @ w_iclr_up).astype(f32))
    g = (jax.nn.sigmoid(zg) @ w_gate_up).astype(f32)
    kk = heads(k * k_k)
    kk = kk / jnp.maximum(jnp.sqrt(jnp.sum(kk * kk, axis=-1, keepdims=True)), 1e-12)
    k_f = k.astype(f32) * (1.0 + (a - 1.0) * k_a.astype(f32))
    rh, kh, vh, ah, wh = heads(r), heads(k_f), heads(v), heads(a), heads(decay)
    y = wkv7_scan(rh, wh, kh, vh, -kk, kk * ah)
    mu = jnp.mean(y, axis=-1, keepdims=True)
    var = jnp.mean(jnp.square(y - mu), axis=-1, keepdims=True)
    y = ((y - mu) * lax.rsqrt(var + LNX_EPS)).reshape(B, S, C) * lnx_g.astype(f32) + lnx_b.astype(f32)
    bonus = jnp.sum(rh * kh * r_k.astype(f32), axis=-1, keepdims=True) * vh
    return ((y + bonus.reshape(B, S, C)) * g).astype(r.dtype)


def sliding_window_attention(q, k, v, sinks):
    B, S = q.shape[:2]
    nb = S // WINDOW
    qb = q.reshape(B, nb, WINDOW, KV_HEADS, GROUP, HEAD_DIM)
    def with_prev(t):
        t = t.reshape(B, nb, WINDOW, KV_HEADS, HEAD_DIM)
        prev = jnp.pad(t[:, :-1], ((0, 0), (1, 0), (0, 0), (0, 0), (0, 0)))
        return jnp.concatenate([prev, t], axis=2)
    kc, vc = with_prev(k), with_prev(v)
    s = jnp.einsum('bnqhgd,bnkhd->bnhgqk', qb, kc).astype(jnp.float32) * (HEAD_DIM ** -0.5)
    qi = jnp.arange(WINDOW)[:, None]
    kj = jnp.arange(2 * WINDOW)[None, :]
    band = (kj > qi) & (kj <= qi + WINDOW)
    first = (jnp.arange(nb) == 0)[:, None, None]
    valid = band[None] & ~(first & (kj < WINDOW)[None])
    s = jnp.where(valid[None, :, None, None], s, -jnp.inf)
    sink = sinks.astype(jnp.float32).reshape(KV_HEADS, GROUP)[None, None, :, :, None, None]
    m = jnp.maximum(jnp.max(s, axis=-1, keepdims=True), sink)
    p = jnp.exp(s - m)
    p = p / (jnp.sum(p, axis=-1, keepdims=True) + jnp.exp(sink - m))
    o = jnp.einsum('bnhgqk,bnkhd->bnqhgd', p.astype(v.dtype), vc)
    return o.reshape(B, S, ATTN_HEADS * HEAD_DIM)


def mixer_block(h, w_in, mix_mu, w0, w_decay_up, a0, w_iclr_up, w_gate_up, k_k, k_a, r_k, lnx_g, lnx_b, b_qkv, sinks, w_up_rwkv, w_up_attn, w_out):
    B, S, _ = h.shape
    z = h @ w_in
    z_rwkv = z[..., :RWKV_COLS]
    z_rwkv = z_rwkv + (token_shift(z_rwkv) - z_rwkv) * mix_mu
    r, k, v, zw, za, zg = _split(z_rwkv, RWKV_SPLITS)
    qkv = z[..., RWKV_COLS:RWKV_COLS + QKV_COLS] + b_qkv
    q, ka, va = _split(qkv, QKV_SPLITS)
    gate_rwkv, gate_attn = _split(z[..., RWKV_COLS + QKV_COLS:], (D_MODEL, D_MODEL))
    y_rwkv = rwkv7_time_mix(r, k, v, zw, za, zg, w0, w_decay_up, a0, w_iclr_up, w_gate_up, k_k, k_a, r_k, lnx_g, lnx_b)
    y_attn = sliding_window_attention(q.reshape(B, S, ATTN_HEADS, HEAD_DIM), ka.reshape(B, S, KV_HEADS, HEAD_DIM), va.reshape(B, S, KV_HEADS, HEAD_DIM), sinks)
    merged = jax.nn.sigmoid(gate_rwkv) * (y_rwkv @ w_up_rwkv) + jax.nn.sigmoid(gate_attn) * (y_attn @ w_up_attn)
    return merged @ w_out


def moe_ffn(h, w_router, b_router, w1, b1, w2, b2):
    B, S, D = h.shape
    f32 = jnp.float32
    n_tok = B * S
    hf = h.reshape(n_tok, D)
    logits = (hf @ w_router).astype(f32) + b_router.astype(f32)
    top_val, top_idx = lax.top_k(logits, TOP_K)
    gate = jax.nn.softmax(top_val, axis=-1)
    n_assign = n_tok * TOP_K
    flat_e = top_idx.reshape(-1).astype(jnp.int32)
    order = jnp.argsort(flat_e)
    sorted_e = flat_e[order]
    sorted_tok = (order // TOP_K).astype(jnp.int32)
    sorted_gate = gate.reshape(-1)[order]
    counts = jnp.bincount(flat_e, length=N_EXPERTS).astype(jnp.int32)
    padded = (counts + MOE_BLOCK - 1) // MOE_BLOCK * MOE_BLOCK
    pad_end = jnp.cumsum(padded)
    pad_start = pad_end - padded
    grp_start = jnp.cumsum(counts) - counts
    dest = pad_start[sorted_e] + jnp.arange(n_assign, dtype=jnp.int32) - grp_start[sorted_e]
    n_blocks = -(-n_assign // MOE_BLOCK) + N_EXPERTS
    n_rows = n_blocks * MOE_BLOCK
    row_tok = jnp.zeros((n_rows,), jnp.int32).at[dest].set(sorted_tok)
    row_gate = jnp.zeros((n_rows,), f32).at[dest].set(sorted_gate)
    block_start = jnp.arange(n_blocks, dtype=jnp.int32) * MOE_BLOCK
    block_expert = jnp.minimum(jnp.searchsorted(pad_end, block_start, side='right'), N_EXPERTS - 1).astype(jnp.int32)
    def block_step(acc, inp):
        tok, gw, e = inp
        hid = hf[tok] @ w1[e] + b1[e]
        glu = jnp.minimum(hid[:, :D_FF], SWIGLU_LIMIT)
        lin = jnp.clip(hid[:, D_FF:], -SWIGLU_LIMIT, SWIGLU_LIMIT)
        act = glu * jax.nn.sigmoid(SWIGLU_ALPHA * glu) * (lin + 1.0)
        yb = act @ w2[e] + b2[e]
        return acc.at[tok].add(yb.astype(f32) * gw[:, None]), None
    acc, _ = lax.scan(block_step, jnp.zeros((n_tok, D), f32), (row_tok.reshape(n_blocks, MOE_BLOCK), row_gate.reshape(n_blocks, MOE_BLOCK), block_expert))
    return acc.reshape(B, S, D).astype(h.dtype)


def setup_inputs(seed: int = 0) -> dict:
    key = jax.random.key(seed)
    ks = iter(jax.random.split(key, 32))
    f32 = jnp.float32
    L = DEPTH
    C = RWKV_WIDTH
    def nrm(shape, scale):
        return jax.random.normal(next(ks), shape, f32) * scale
    def gain(shape):
        return 1.0 + nrm(shape, 0.02)
    return {
        'x': nrm((BATCH, SEQ, D_MODEL), 1.0),
        'norm1_g': gain((L, D_MODEL)),
        'w_in': nrm((L, D_MODEL, IN_COLS), D_MODEL ** -0.5),
        'mix_mu': jax.random.uniform(next(ks), (L, RWKV_COLS), f32),
        'w0': jax.random.uniform(next(ks), (L, C), f32, -5.0, -0.5),
        'w_decay_up': nrm((L, DECAY_LORA, C), 0.5 * DECAY_LORA ** -0.5),
        'a0': nrm((L, C), 0.5),
        'w_iclr_up': nrm((L, ICLR_LORA, C), ICLR_LORA ** -0.5),
        'w_gate_up': nrm((L, GATE_LORA, C), GATE_LORA ** -0.5),
        'k_k': 0.85 + nrm((L, C), 0.05),
        'k_a': 1.0 + nrm((L, C), 0.05),
        'r_k': nrm((L, RWKV_HEADS, RWKV_HEAD), 0.1),
        'lnx_g': gain((L, C)),
        'lnx_b': nrm((L, C), 0.02),
        'b_qkv': nrm((L, QKV_COLS), 0.02),
        'sinks': nrm((L, ATTN_HEADS), 0.5),
        'w_up_rwkv': nrm((L, C, D_MODEL), C ** -0.5),
        'w_up_attn': nrm((L, ATTN_HEADS * HEAD_DIM, D_MODEL), (ATTN_HEADS * HEAD_DIM) ** -0.5),
        'w_out': nrm((L, D_MODEL, D_MODEL), D_MODEL ** -0.5),
        'norm2_g': gain((L, D_MODEL)),
        'w_router': nrm((L, D_MODEL, N_EXPERTS), D_MODEL ** -0.5),
        'b_router': nrm((L, N_EXPERTS), 0.01),
        'w1': nrm((L, N_EXPERTS, D_MODEL, 2 * D_FF), D_MODEL ** -0.5),
        'b1': nrm((L, N_EXPERTS, 2 * D_FF), 0.02),
        'w2': nrm((L, N_EXPERTS, D_FF, D_MODEL), D_FF ** -0.5),
        'b2': nrm((L, N_EXPERTS, D_MODEL), 0.02),
        'normf_g': gain((D_MODEL,)),
    }


def reference(x, norm1_g, w_in, mix_mu, w0, w_decay_up, a0, w_iclr_up, w_gate_up, k_k, k_a, r_k, lnx_g, lnx_b, b_qkv, sinks, w_up_rwkv, w_up_attn, w_out, norm2_g, w_router, b_router, w1, b1, w2, b2, normf_g):
    for l in range(DEPTH):
        h = rms_norm(x, norm1_g[l])
        x = x + mixer_block(h, w_in[l], mix_mu[l], w0[l], w_decay_up[l], a0[l], w_iclr_up[l], w_gate_up[l], k_k[l], k_a[l], r_k[l], lnx_g[l], lnx_b[l], b_qkv[l], sinks[l], w_up_rwkv[l], w_up_attn[l], w_out[l])
        h = rms_norm(x, norm2_g[l])
        x = x + moe_ffn(h, w_router[l], b_router[l], w1[l], b1[l], w2[l], b2[l])
    return rms_norm(x, normf_g)
```

```cpp
#include <hip/hip_runtime.h>
#include <cstdio>
#include <cstdint>

#ifndef MK_N_LAUNCHES
#define MK_N_LAUNCHES 1
#endif

#define LAS __attribute__((address_space(3)))
typedef unsigned short bf16;
typedef unsigned v4u __attribute__((ext_vector_type(4)));
typedef unsigned v2u __attribute__((ext_vector_type(2)));
typedef float f32x4 __attribute__((ext_vector_type(4)));
typedef float f32x2 __attribute__((ext_vector_type(2)));
typedef short bf16x8 __attribute__((ext_vector_type(8)));
typedef int v4i __attribute__((ext_vector_type(4)));
typedef int v8i __attribute__((ext_vector_type(8)));

constexpr int NT = 32768, SEQ = 16384, D = 2048, C = 1024, NH = 16, HD = 64;
constexpr int IN_COLS = 8960;
constexpr int ZC_R = 0, ZC_K = 1024, ZC_V = 2048, ZC_LORA = 3072, ZC_Q = 3328, ZC_KA = 4352, ZC_VA = 4608, ZC_GR = 4864, ZC_GA = 6912;
constexpr int NE = 32, TOPK = 4, DFF = 2048;
constexpr int MAX_TILES = NT * TOPK / 256 + NE;
constexpr int NSLOT = MAX_TILES * 256;
constexpr float NORM_EPS = 1e-5f, LNX_EPS = 64e-5f;

constexpr size_t MiB = 1u << 20;
constexpr size_t WS_CTL = 0, CTL_ZERO_BYTES = 2 * MiB;
constexpr size_t WS_TOPI = 2 * MiB;
constexpr size_t WS_TOPG = 3 * MiB;
constexpr size_t WS_SLOT = 4 * MiB;
constexpr size_t WS_WIN_T = 8 * MiB;
constexpr size_t WS_WUPR_T = 44 * MiB;
constexpr size_t WS_WUPA_T = 48 * MiB;
constexpr size_t WS_WOUT_T = 52 * MiB;
constexpr size_t WS_WD_T = 60 * MiB, WS_WI_T = WS_WD_T + 131072, WS_WG_T = WS_WI_T + 131072;
constexpr size_t WS_WRT = 61 * MiB;
constexpr size_t WS_W1_T = 64 * MiB;
constexpr size_t WS_W2_T = 576 * MiB;
constexpr size_t WS_H = 832 * MiB;
constexpr size_t WS_Z = 960 * MiB;
constexpr size_t WS_SCAN = 1520 * MiB;
constexpr size_t WS_ACT = WS_SCAN;
constexpr size_t WS_YR = 2416 * MiB;
constexpr size_t WS_YA = 2480 * MiB;
constexpr size_t WS_T1 = 2544 * MiB;
constexpr size_t WS_MG = 2672 * MiB;
constexpr size_t WS_Y = 2800 * MiB;
constexpr size_t WS_PST = 3344 * MiB;
constexpr size_t WS_GAM = 3408 * MiB;
constexpr size_t WS_BD = 3410 * MiB;
constexpr size_t WS_X1 = 3412 * MiB;
constexpr size_t WS_GC = 3668 * MiB, WS_HC = 3672 * MiB;
constexpr size_t WS_H1F = 3676 * MiB;
constexpr size_t WS_WING = 3740 * MiB;
constexpr size_t WS_END = 3748 * MiB;
constexpr size_t SC_R = 0, SC_KF = 64 * MiB, SC_V = 128 * MiB, SC_AN = 192 * MiB, SC_BN = 256 * MiB, SC_G = 320 * MiB;
constexpr size_t SC_LW = 384 * MiB;
constexpr size_t SC_QR = 512 * MiB;
constexpr size_t SC_YL = 576 * MiB;
constexpr size_t SC_E = 704 * MiB;
constexpr size_t SC_HP = 768 * MiB;
constexpr int CW_BAR = 1024;
constexpr int CW_CNT = 8192;
constexpr int CW_CUR = 8192 + 64;
constexpr int CW_ATTQ = 8192 + 192;
constexpr int CW_TOKSLOT = 16384;
constexpr int CW_RSS = CW_TOKSLOT + NSLOT;
static_assert((CW_RSS + NSLOT) * 4 <= (int)CTL_ZERO_BYTES, "ctl");

constexpr int RING_BYTES = 131072;
constexpr int TAB_OFF = RING_BYTES;
constexpr int MISC_OFF = RING_BYTES + 4096;
constexpr int LDS_BYTES = 147456;

#define RLX_AGENT __ATOMIC_RELAXED, __HIP_MEMORY_SCOPE_AGENT
#define LDS_WAIT() asm volatile("s_waitcnt lgkmcnt(0)" ::: "memory")
#define VM_WAIT() asm volatile("s_waitcnt vmcnt(0)" ::: "memory")
__device__ __forceinline__ unsigned f2bf(float f) { return (unsigned)__builtin_bit_cast(unsigned short, (__bf16)f); }
typedef __bf16 bf2_t __attribute__((ext_vector_type(2)));
typedef short s16x4 __attribute__((ext_vector_type(4)));
__device__ __forceinline__ unsigned pk2(float lo, float hi) { bf2_t v; v[0] = (__bf16)lo; v[1] = (__bf16)hi; return __builtin_bit_cast(unsigned, v); }
__device__ __forceinline__ unsigned pk4_fp8(float a, float b, float c, float d) { unsigned w = 0u; w = __builtin_amdgcn_cvt_pk_fp8_f32(a, b, w, false); w = __builtin_amdgcn_cvt_pk_fp8_f32(c, d, w, true); return w; }
__device__ __forceinline__ float bflo(unsigned w) { return __builtin_bit_cast(float, w << 16); }
__device__ __forceinline__ float bfhi(unsigned w) { return __builtin_bit_cast(float, w & 0xffff0000u); }
__device__ __forceinline__ float bf1(bf16 b) { return __builtin_bit_cast(float, (unsigned)b << 16); }
__device__ __forceinline__ float sigmoidf_(float x) { return __builtin_amdgcn_rcpf(1.0f + __expf(-x)); }
__device__ __forceinline__ float wave_sum(float v) {
#pragma unroll
    for (int o = 1; o < 64; o <<= 1) v += __shfl_xor(v, o);
    return v;
}

#define XB_TMO      128
#define XB_XCNT(j)  (256  + 64 * (j))
#define XB_XSUB(j)  (1280 + 64 * (j))
#define XB_XGEN(j)  (2304 + 64 * (j))
#define XB_TOP      3328
#define XB_TOPGEN   3392
#define XCD_BAR_WORDS 3456
#define XB_SPIN_CAP (1u << 22)
__device__ __forceinline__ unsigned xb_ld(unsigned* p)              { return __hip_atomic_load(p, __ATOMIC_RELAXED, __HIP_MEMORY_SCOPE_AGENT); }
__device__ __forceinline__ unsigned xb_add(unsigned* p, unsigned v) { return __hip_atomic_fetch_add(p, v, __ATOMIC_RELAXED, __HIP_MEMORY_SCOPE_AGENT); }
__device__ __forceinline__ unsigned xb_xcc_id() { return (unsigned)__builtin_amdgcn_s_getreg((3 << 11) | 20) & 0xFu; }
#define XB_SPIN(cond, bar) do { unsigned _sp = 0; while (cond) { __builtin_amdgcn_s_sleep(1); \
    if ((++_sp & 255u) == 0u) { if (xb_ld(&(bar)[XB_TMO])) break; if (_sp > XB_SPIN_CAP) { atomicAdd(&(bar)[XB_TMO], 1u); break; } } } } while (0)
struct XcdBarrier { unsigned* bar; unsigned x; volatile LAS unsigned* st; };
__device__ __forceinline__ XcdBarrier xcd_barrier_post(unsigned* bar, volatile LAS unsigned* st) {
    XcdBarrier b; b.bar = bar; b.x = xb_xcc_id(); b.st = st;
    if (threadIdx.x == 0) (void)xb_add(&bar[XB_XCNT(b.x)], 1u);
    return b;
}
__device__ __forceinline__ void xcd_barrier_complete(unsigned* bar, unsigned x, unsigned& nloc, unsigned& nx) {
    const unsigned G = gridDim.x * gridDim.y * gridDim.z;
    unsigned sum, cnt, mine, sp = 0u;
    for (;;) {
        sum = 0u; cnt = 0u; mine = 0u;
#pragma unroll
        for (unsigned j = 0; j < 16; ++j) { const unsigned c = xb_ld(&bar[XB_XCNT(j)]); sum += c; cnt += (c > 0u) ? 1u : 0u; mine = (j == x) ? c : mine; }
        if (sum == G) break;
        __builtin_amdgcn_s_sleep(1);
        if ((++sp & 255u) == 0u) { if (xb_ld(&bar[XB_TMO])) break; if (sp > XB_SPIN_CAP) { atomicAdd(&bar[XB_TMO], 1u); break; } }
    }
    nloc = mine > 0u ? mine : 1u; nx = cnt > 0u ? cnt : 1u;
}
__device__ __forceinline__ void xcd_barrier(const XcdBarrier& b) {
    asm volatile("s_waitcnt vmcnt(0)" ::: "memory");
    __syncthreads();
    if (threadIdx.x == 0) {
        unsigned* bar = b.bar;
        __builtin_amdgcn_s_waitcnt(0);
        unsigned nloc = b.st[0], nx = b.st[1];
        if (nloc == 0u) { xcd_barrier_complete(bar, b.x, nloc, nx); b.st[0] = nloc; b.st[1] = nx; }
        const unsigned old = xb_add(&bar[XB_XSUB(b.x)], 1u);
        const unsigned gen = old / nloc;
        if (old + 1u == (gen + 1u) * nloc) {
            __builtin_amdgcn_fence(__ATOMIC_RELEASE, "agent");
            asm volatile("s_waitcnt vmcnt(0)" ::: "memory");
            const unsigned og = xb_add(&bar[XB_TOP], 1u);
            const unsigned tg = og / nx;
            if (og + 1u == (tg + 1u) * nx) xb_add(&bar[XB_TOPGEN], 1u);
            else XB_SPIN(xb_ld(&bar[XB_TOPGEN]) == tg, bar);
            __builtin_amdgcn_fence(__ATOMIC_ACQUIRE, "agent");
            xb_add(&bar[XB_XGEN(b.x)], 1u);
            asm volatile("s_waitcnt vmcnt(0)" ::: "memory");
        } else {
            XB_SPIN(xb_ld(&bar[XB_XGEN(b.x)]) == gen, bar);
            __builtin_amdgcn_fence(__ATOMIC_ACQUIRE, "agent");
            asm volatile("s_waitcnt vmcnt(0)" ::: "memory");
        }
    }
    __syncthreads();
}

namespace pg8 {
constexpr int BM = 256, BK = 64, HALF = 128, HTB = HALF * BK * 2, STAGE_BYTES = 8 * HTB, NXCD = 8, WGM = 8;
__device__ __forceinline__ int lds_byte(int r, int c) { const int st = (r >> 4) * 2 + (c >> 5), rr = r & 15, cc = c & 31, ob = rr * 64 + cc * 2; return st * 1024 + (ob ^ (((ob >> 9) & 1) << 5)); }
__device__ __forceinline__ void stage_rc(int b, int& R, int& Cc) { const int st = b / 1024, sb = b % 1024, swz = sb ^ (((sb >> 9) & 1) << 5); R = (st >> 1) * 16 + swz / 64; Cc = (st & 1) * 32 + (swz % 64) / 2; }
__device__ __forceinline__ int perm32(int rho) { const int n = rho >> 4, i = rho & 15; return 8 * (i >> 2) + 4 * n + (i & 3); }
struct Unit { int pm, pn, e; };
__device__ __forceinline__ int xcd_remap(int wgid, int nwg) { const int q = nwg / NXCD, r = nwg % NXCD, xcd = wgid % NXCD, off = wgid / NXCD; return (xcd < r ? xcd * (q + 1) : r * (q + 1) + (xcd - r) * q) + off; }
struct DenseOrder {
    int nM, nN, nwg, G, c, first = 0, count = -1;
    __device__ __forceinline__ void init(int M, int N, int G_, int c_) { nM = M / BM; nN = N / BM; nwg = nM * nN; G = G_; c = c_; }
    __device__ __forceinline__ bool next(int i, Unit& u) const {
        long L = (long)i * G + c; if (L >= (count >= 0 ? count : nwg)) return false;
        L += first;
        const int wgid = xcd_remap((int)L, nwg);
        const int nig = WGM * nN, gid = wgid / nig, fm = gid * WGM, gsz = (nM - fm) < WGM ? (nM - fm) : WGM;
        u.pm = fm + ((wgid % nig) % gsz); u.pn = (wgid % nig) / gsz; u.e = 0; return true;
    }
};
struct BalancedOrder {
    int nM, nN, nwg, G, c, rem, base, extra;
    __device__ __forceinline__ void init(int M, int N, int G_, int c_, int rem_, int extra_) { nM = M / BM; nN = N / BM; nwg = nM * nN; G = G_; c = c_; rem = rem_; extra = extra_;
        const int t = nwg - extra_ * (G_ - rem_); base = (t >= 0 && t % G_ == 0) ? t / G_ : -1; }
    __device__ __forceinline__ bool next(int i, Unit& u) const {
        long L;
        if (base < 0) { L = (long)i * G + c; if (L >= nwg) return false; }
        else if (i < base) L = (long)i * G + c;
        else if (c >= rem && i < base + extra) L = (long)base * G + (long)(i - base) * (G - rem) + (c - rem);
        else return false;
        const int wgid = xcd_remap((int)L, nwg);
        const int nig = WGM * nN, gid = wgid / nig, fm = gid * WGM, gsz = (nM - fm) < WGM ? (nM - fm) : WGM;
        u.pm = fm + ((wgid % nig) % gsz); u.pn = (wgid % nig) / gsz; u.e = 0; return true;
    }
};
template <int NPN> struct MoeOrder {
    const LAS int* tile_e; int ntiles, G, c;
    __device__ __forceinline__ bool next(int i, Unit& u) const {
        const long L = (long)i * G + c; const int nwg = ntiles * NPN; if (L >= nwg) return false;
        const int wgid = xcd_remap((int)L, nwg);
        { const int nig = WGM * NPN, gid = wgid / nig, fm = gid * WGM, gsz = (ntiles - fm) < WGM ? (ntiles - fm) : WGM;
          u.pm = fm + ((wgid % nig) % gsz); u.pn = (wgid % nig) / gsz; }
        u.e = __builtin_amdgcn_readfirstlane(tile_e[u.pm]); return true;
    }
};
typedef f32x4 Acc[2][2][4][2];

template <class Prob>
__device__ __forceinline__ void gemm_phase(LAS unsigned char* lds, const Prob& P) {
    int tid = threadIdx.x; asm volatile("" : "+v"(tid));
    const int wid = __builtin_amdgcn_readfirstlane(tid >> 6), lane = tid & 63, wr = wid >> 2, wc = wid & 3, fr = lane & 15, fq = lane >> 4;
    const int K = P.K, nt = Prob::FP8 ? K / 128 : K / BK;
    constexpr int EB = Prob::FP8 ? 1 : 2;
    unsigned voffB[2], voffA[2]; int Rst[2]; unsigned cst[2];
#pragma unroll
    for (int i = 0; i < 2; ++i) { int R, Cc; stage_rc(tid * 16 + i * 8192, R, Cc); const int p_ = perm32(R & 31); const int Rb = Prob::PERM64 ? (64 * (R >> 5) + 16 * (p_ >> 3) + (p_ & 7)) : (Prob::PERM ? ((R & ~31) + p_) : R);
        Rst[i] = R; cst[i] = (unsigned)Cc * 2u; voffA[i] = (unsigned)(R * K * EB + Cc * 2); voffB[i] = (unsigned)(Rb * K * EB + Cc * 2); }
    const size_t kstep = (size_t)(BK * 2);
    const unsigned ldsw = (unsigned)wid * 1024u;
    const int aoff = lds_byte(wr * 64 + fr, fq * 8), boff = lds_byte(wc * 32 + fr, fq * 8);
#define PG8_SA(b, h) (((b) * 2 + (h)) * HTB)
#define PG8_SB(b, h) ((4 + (b) * 2 + (h)) * HTB)
#define PG8_STAGE(bufoff, gbase, v0, v1) do { \
        __builtin_amdgcn_global_load_lds((const unsigned*)((const char*)(gbase) + (v0)), (LAS unsigned*)(lds + (bufoff) + ldsw), 16, 0, 0); \
        __builtin_amdgcn_global_load_lds((const unsigned*)((const char*)(gbase) + (v1)), (LAS unsigned*)(lds + (bufoff) + ldsw + 8192), 16, 0, 0); } while (0)
#define PG8_LD8(dst, off) do { const v4i lo_ = *(const LAS v4i*)(lds + (off)); const v4i hi_ = *(const LAS v4i*)(lds + (off) + 1024); dst = __builtin_shufflevector(lo_, hi_, 0, 1, 2, 3, 4, 5, 6, 7); } while (0)
#define PG8_LDA(dst, b, h) do { _Pragma("unroll") for (int m = 0; m < 4; ++m) PG8_LD8(dst[m], PG8_SA(b, h) + aoff + m * 2048); } while (0)
#define PG8_LDB(dst, b, h) do { _Pragma("unroll") for (int n = 0; n < 2; ++n) PG8_LD8(dst[n], PG8_SB(b, h) + boff + n * 2048); } while (0)
#define PG8_MMA(ai, bj, At, Bt) do { __builtin_amdgcn_s_setprio(1); if constexpr (Prob::FP8) asm volatile("s_nop 1"); _Pragma("unroll") for (int m = 0; m < 4; ++m) _Pragma("unroll") for (int n = 0; n < 2; ++n) { \
        if constexpr (Prob::FP8) asm volatile("v_mfma_scale_f32_16x16x128_f8f6f4 %0, %1, %2, %0, %3, %4 op_sel_hi:[0,0,0]" : "+v"(acc[ai][bj][m][n]) : "v"(Bt[n]), "v"(At[m]), "v"(sc_w), "v"(sc_a));   \
        else { acc[ai][bj][m][n] = __builtin_amdgcn_mfma_f32_16x16x32_bf16((bf16x8)__builtin_shufflevector(Bt[n], Bt[n], 0, 1, 2, 3), (bf16x8)__builtin_shufflevector(At[m], At[m], 0, 1, 2, 3), acc[ai][bj][m][n], 0, 0, 0); \
               acc[ai][bj][m][n] = __builtin_amdgcn_mfma_f32_16x16x32_bf16((bf16x8)__builtin_shufflevector(Bt[n], Bt[n], 4, 5, 6, 7), (bf16x8)__builtin_shufflevector(At[m], At[m], 4, 5, 6, 7), acc[ai][bj][m][n], 0, 0, 0); } } \
        __builtin_amdgcn_s_setprio(0); } while (0)
#define PG8_WAIT_V(n) asm volatile("s_waitcnt vmcnt(" #n ")" ::: "memory")
#define PG8_WAIT_L(n) asm volatile("s_waitcnt lgkmcnt(" #n ")" ::: "memory")
#define PG8_BAR __builtin_amdgcn_s_barrier()
#define PG8_SCHED __builtin_amdgcn_sched_barrier(0)
    Unit cur, nxt; int ui = 0;
    if (!P.next(0, cur)) return;
    Acc acc;
#pragma unroll
    for (int a = 0; a < 2; ++a)
#pragma unroll
        for (int b = 0; b < 2; ++b)
#pragma unroll
            for (int m = 0; m < 4; ++m)
#pragma unroll
                for (int n = 0; n < 2; ++n) acc[a][b][m][n] = (f32x4){0.f, 0.f, 0.f, 0.f};
    v8i At[4], B0[2], B1[2];
    int sc_w = 121, sc_a = 127;
    if constexpr (Prob::FP8) asm volatile("" : "+v"(sc_w), "+v"(sc_a));
    const char *cA0 = P.a_base(cur, 0), *cA1 = P.a_base(cur, 1), *cB0 = P.b_base(cur, 0), *cB1 = P.b_base(cur, 1);
    unsigned c00 = voffA[0], c01 = voffA[1], c10 = voffA[0], c11 = voffA[1];
    unsigned n00 = c00, n01 = c01, n10 = c10, n11 = c11;
    if constexpr (Prob::GATHER) { c00 = P.gather(cur, 0, Rst[0]) + cst[0]; c01 = P.gather(cur, 0, Rst[1]) + cst[1]; c10 = P.gather(cur, 1, Rst[0]) + cst[0]; c11 = P.gather(cur, 1, Rst[1]) + cst[1]; }
    PG8_STAGE(PG8_SB(0, 0), cB0, voffB[0], voffB[1]); PG8_STAGE(PG8_SB(0, 1), cB1, voffB[0], voffB[1]); PG8_STAGE(PG8_SA(0, 0), cA0, c00, c01); PG8_STAGE(PG8_SA(0, 1), cA1, c10, c11);
    if (wr == 1) PG8_BAR;
    PG8_WAIT_V(2); PG8_BAR;
    PG8_STAGE(PG8_SB(1, 0), cB0 + kstep, voffB[0], voffB[1]); PG8_STAGE(PG8_SB(1, 1), cB1 + kstep, voffB[0], voffB[1]);
    PG8_WAIT_V(4); PG8_BAR;
    for (;;) {
        const bool has_next = P.next(ui + 1, nxt);
        const char *nA0 = cA0, *nA1 = cA1, *nB0 = cB0, *nB1 = cB1;
        if (has_next) { nA0 = P.a_base(nxt, 0); nA1 = P.a_base(nxt, 1); nB0 = P.b_base(nxt, 0); nB1 = P.b_base(nxt, 1); }
        if constexpr (Prob::GATHER) {
            if (has_next) { n00 = P.gather(nxt, 0, Rst[0]) + cst[0]; n01 = P.gather(nxt, 0, Rst[1]) + cst[1]; n10 = P.gather(nxt, 1, Rst[0]) + cst[0]; n11 = P.gather(nxt, 1, Rst[1]) + cst[1]; }
            else { n00 = c00; n01 = c01; n10 = c10; n11 = c11; }
        }
        for (int t = 0; t < nt; t += 2) {
            const bool last = (t == nt - 2);
            const char* a1h1 = cA1 + (size_t)(t + 1) * kstep;
            const char* a2h0 = last ? nA0 : cA0 + (size_t)(t + 2) * kstep; const char* a2h1 = last ? nA1 : cA1 + (size_t)(t + 2) * kstep;
            const char* b2h0 = last ? nB0 : cB0 + (size_t)(t + 2) * kstep; const char* b2h1 = last ? nB1 : cB1 + (size_t)(t + 2) * kstep;
            const char* b3h0 = b2h0 + kstep; const char* b3h1 = b2h1 + kstep;
            unsigned v00 = c00, v01 = c01, v10 = c10, v11 = c11;
            if constexpr (Prob::GATHER) { if (last) { v00 = n00; v01 = n01; v10 = n10; v11 = n11; }
                asm volatile("" : "+v"(v00), "+v"(v01), "+v"(v10), "+v"(v11)); }
            unsigned w10 = c10, w11 = c11; if constexpr (Prob::GATHER) asm volatile("" : "+v"(w10), "+v"(w11));
            const char* a1h0 = cA0 + (size_t)(t + 1) * kstep;
            unsigned w00 = c00, w01 = c01; if constexpr (Prob::GATHER) asm volatile("" : "+v"(w00), "+v"(w01));
            PG8_LDB(B0, 0, 0); PG8_LDB(B1, 0, 1); PG8_SCHED; PG8_LDA(At, 0, 0); PG8_STAGE(PG8_SA(1, 0), a1h0, w00, w01); PG8_STAGE(PG8_SA(1, 1), a1h1, w10, w11);
            PG8_WAIT_V(8); PG8_WAIT_L(0); PG8_BAR; PG8_MMA(0, 0, At, B0); PG8_MMA(0, 1, At, B1); PG8_BAR; PG8_SCHED;
            PG8_LDA(At, 0, 1); PG8_STAGE(PG8_SB(0, 0), b2h0, voffB[0], voffB[1]); PG8_STAGE(PG8_SB(0, 1), b2h1, voffB[0], voffB[1]);
            PG8_WAIT_V(6); PG8_WAIT_L(0); PG8_BAR; PG8_MMA(1, 0, At, B0); PG8_MMA(1, 1, At, B1); PG8_BAR; PG8_SCHED;
            PG8_LDB(B0, 1, 0); PG8_LDB(B1, 1, 1); PG8_SCHED; PG8_LDA(At, 1, 0); PG8_STAGE(PG8_SA(0, 0), a2h0, v00, v01); PG8_STAGE(PG8_SA(0, 1), a2h1, v10, v11);
            PG8_WAIT_V(8); PG8_WAIT_L(0); PG8_BAR; PG8_MMA(0, 0, At, B0); PG8_MMA(0, 1, At, B1); PG8_BAR; PG8_SCHED;
            PG8_LDA(At, 1, 1); PG8_STAGE(PG8_SB(1, 0), b3h0, voffB[0], voffB[1]); PG8_STAGE(PG8_SB(1, 1), b3h1, voffB[0], voffB[1]);
            PG8_WAIT_V(6); PG8_WAIT_L(0); PG8_BAR; PG8_MMA(1, 0, At, B0); PG8_MMA(1, 1, At, B1); PG8_BAR; PG8_SCHED;
        }
        if (wr == 0) PG8_BAR;
        if constexpr (Prob::FP8) asm volatile("s_nop 15\n\ts_nop 15" ::: "memory");
        P.epi(acc, cur, wr, wc, fr, fq);
        if (!has_next) break;
#pragma unroll
        for (int a = 0; a < 2; ++a)
#pragma unroll
            for (int b = 0; b < 2; ++b)
#pragma unroll
                for (int m = 0; m < 4; ++m)
#pragma unroll
                    for (int n = 0; n < 2; ++n) acc[a][b][m][n] = (f32x4){0.f, 0.f, 0.f, 0.f};
        cur = nxt; cA0 = nA0; cA1 = nA1; cB0 = nB0; cB1 = nB1; ++ui;
        if constexpr (Prob::GATHER) { c00 = n00; c01 = n01; c10 = n10; c11 = n11; }
        if (wr == 1) PG8_BAR;
    }
    PG8_WAIT_V(0);
    PG8_BAR;
#undef PG8_SA
#undef PG8_SB
#undef PG8_STAGE
#undef PG8_LD8
#undef PG8_LDA
#undef PG8_LDB
#undef PG8_MMA
#undef PG8_WAIT_V
#undef PG8_WAIT_L
#undef PG8_BAR
#undef PG8_SCHED
}
}

using pg8::Unit; using pg8::Acc;
struct ProbIn {
    static constexpr bool PERM = true, GATHER = false, FP8 = false, PERM64 = false;
    int K; pg8::DenseOrder S; const bf16* A; const bf16* Bt; bf16* Z; const float* bqkv;
    __device__ __forceinline__ bool next(int i, Unit& u) const { return S.next(i, u); }
    __device__ __forceinline__ const char* a_base(const Unit& u, int h) const { return (const char*)A + (size_t)(u.pm * 256 + h * 128) * K * 2; }
    __device__ __forceinline__ const char* b_base(const Unit& u, int h) const { return (const char*)Bt + (size_t)(u.pn * 256 + h * 128) * K * 2; }
    __device__ __forceinline__ void epi(const Acc& acc, const Unit& u, int wr, int wc, int fr, int fq) const {
        const int row0 = u.pm * 256 + wr * 64 + fr, col0 = u.pn * 256 + wc * 32 + 8 * fq;
        const int mode = u.pn < 13 ? 0 : 1;
        f32x4 bv[2][2];
#pragma unroll
        for (int bj = 0; bj < 2; ++bj)
#pragma unroll
            for (int n = 0; n < 2; ++n) bv[bj][n] = (mode == 1) ? *(const f32x4*)(bqkv + (col0 - ZC_Q) + bj * 128 + 4 * n) : (f32x4){0.f, 0.f, 0.f, 0.f};
#pragma unroll
        for (int ai = 0; ai < 2; ++ai)
#pragma unroll
            for (int m = 0; m < 4; ++m) { bf16* rowp = Z + (size_t)(row0 + ai * 128 + m * 16) * IN_COLS + col0;
#pragma unroll
                for (int bj = 0; bj < 2; ++bj) { f32x4 v0 = acc[ai][bj][m][0] + bv[bj][0], v1 = acc[ai][bj][m][1] + bv[bj][1];
                    v4u w; w.x = pk2(v0[0], v0[1]); w.y = pk2(v0[2], v0[3]); w.z = pk2(v1[0], v1[1]); w.w = pk2(v1[2], v1[3]);
                    *(v4u*)(rowp + bj * 128) = w; } }
    }
};
struct ProbInG {
    static constexpr bool PERM = true, GATHER = false, FP8 = true, PERM64 = false;
    int K; pg8::BalancedOrder S; const unsigned char* A; const unsigned char* Bt; bf16* Z;
    __device__ __forceinline__ bool next(int i, Unit& u) const { return S.next(i, u); }
    __device__ __forceinline__ const char* a_base(const Unit& u, int h) const { return (const char*)A + (size_t)(u.pm * 256 + h * 128) * K; }
    __device__ __forceinline__ const char* b_base(const Unit& u, int h) const { return (const char*)Bt + (size_t)(u.pn * 256 + h * 128) * K; }
    __device__ __forceinline__ void epi(const Acc& acc, const Unit& u, int wr, int wc, int fr, int fq) const {
        const int row0 = u.pm * 256 + wr * 64 + fr, col0 = ZC_GR + u.pn * 256 + wc * 32 + 8 * fq;
#pragma unroll
        for (int ai = 0; ai < 2; ++ai)
#pragma unroll
            for (int m = 0; m < 4; ++m) { bf16* rowp = Z + (size_t)(row0 + ai * 128 + m * 16) * IN_COLS + col0;
#pragma unroll
                for (int bj = 0; bj < 2; ++bj) { f32x4 v0 = acc[ai][bj][m][0], v1 = acc[ai][bj][m][1];
#pragma unroll
                    for (int j = 0; j < 4; ++j) { v0[j] = sigmoidf_(v0[j]); v1[j] = sigmoidf_(v1[j]); }
                    v4u w; w.x = pk2(v0[0], v0[1]); w.y = pk2(v0[2], v0[3]); w.z = pk2(v1[0], v1[1]); w.w = pk2(v1[2], v1[3]);
                    *(v4u*)(rowp + bj * 128) = w; } }
    }
};
template <int MODE> struct ProbUp {
    static constexpr bool PERM = true, GATHER = false, FP8 = true, PERM64 = false;
    int K; pg8::DenseOrder S; const bf16* A; const bf16* Bt; const bf16* Z; const bf16* T1in; bf16* O;
    __device__ __forceinline__ bool next(int i, Unit& u) const { return S.next(i, u); }
    __device__ __forceinline__ const char* a_base(const Unit& u, int h) const { return (const char*)A + (size_t)(u.pm * 256 + h * 128) * K; }
    __device__ __forceinline__ const char* b_base(const Unit& u, int h) const { return (const char*)Bt + (size_t)(u.pn * 256 + h * 128) * K; }
    __device__ __forceinline__ void epi(const Acc& acc, const Unit& u, int wr, int wc, int fr, int fq) const {
        const int row0 = u.pm * 256 + wr * 64 + fr, col0 = u.pn * 256 + wc * 32 + 8 * fq;
#pragma unroll
        for (int ai = 0; ai < 2; ++ai)
#pragma unroll
            for (int m = 0; m < 4; ++m) { const size_t r = (size_t)(row0 + ai * 128 + m * 16);
#pragma unroll
                for (int bj = 0; bj < 2; ++bj) { const int col = col0 + bj * 128;
                    const v4u g = *(const v4u*)(Z + r * IN_COLS + (MODE == 0 ? ZC_GR : ZC_GA) + col);
                    f32x4 v0 = acc[ai][bj][m][0], v1 = acc[ai][bj][m][1];
                    v0[0] *= bflo(g.x); v0[1] *= bfhi(g.x); v0[2] *= bflo(g.y); v0[3] *= bfhi(g.y); v1[0] *= bflo(g.z); v1[1] *= bfhi(g.z); v1[2] *= bflo(g.w); v1[3] *= bfhi(g.w);
                    if (MODE == 1) { const v4u t = *(const v4u*)(T1in + r * D + col);
                        v0[0] += bflo(t.x); v0[1] += bfhi(t.x); v0[2] += bflo(t.y); v0[3] += bfhi(t.y); v1[0] += bflo(t.z); v1[1] += bfhi(t.z); v1[2] += bflo(t.w); v1[3] += bfhi(t.w); }
                    if (MODE == 1) { v2u w8; w8.x = pk4_fp8(v0[0], v0[1], v0[2], v0[3]); w8.y = pk4_fp8(v1[0], v1[1], v1[2], v1[3]); *(v2u*)((unsigned char*)O + r * D + col) = w8; }
                    else { v4u w; w.x = pk2(v0[0], v0[1]); w.y = pk2(v0[2], v0[3]); w.z = pk2(v1[0], v1[1]); w.w = pk2(v1[2], v1[3]);
                        *(v4u*)(O + r * D + col) = w; } } }
    }
};
struct ProbOut {
    static constexpr bool PERM = true, GATHER = false, FP8 = true, PERM64 = false;
    int K; pg8::DenseOrder S; const bf16* A; const bf16* Bt; const float* X; bf16* O;
    __device__ __forceinline__ bool next(int i, Unit& u) const { return S.next(i, u); }
    __device__ __forceinline__ const char* a_base(const Unit& u, int h) const { return (const char*)A + (size_t)(u.pm * 256 + h * 128) * K; }
    __device__ __forceinline__ const char* b_base(const Unit& u, int h) const { return (const char*)Bt + (size_t)(u.pn * 256 + h * 128) * K; }
    __device__ __forceinline__ void epi(const Acc& acc, const Unit& u, int wr, int wc, int fr, int fq) const {
        const int row0 = u.pm * 256 + wr * 64 + fr, col0 = u.pn * 256 + wc * 32 + 8 * fq;
#pragma unroll
        for (int ai = 0; ai < 2; ++ai)
#pragma unroll
            for (int m = 0; m < 4; ++m) { const size_t off = (size_t)(row0 + ai * 128 + m * 16) * D + col0;
#pragma unroll
                for (int bj = 0; bj < 2; ++bj) { const f32x4 x0 = *(const f32x4*)(X + off + bj * 128), x1v = *(const f32x4*)(X + off + bj * 128 + 4);
                    const f32x4 v0 = x0 + acc[ai][bj][m][0], v1 = x1v + acc[ai][bj][m][1];
                    v4u w; w.x = pk2(v0[0], v0[1]); w.y = pk2(v0[2], v0[3]); w.z = pk2(v1[0], v1[1]); w.w = pk2(v1[2], v1[3]);
                    *(v4u*)(O + off + bj * 128) = w; } }
    }
};
struct ProbMoe1 {
    static constexpr bool PERM = true, GATHER = true, FP8 = true, PERM64 = false;
    int K; pg8::MoeOrder<16> S; const unsigned char* H2; const unsigned char* W1t; const float* b1; const int* tokslot; unsigned char* ACT; const float* rss;
    __device__ __forceinline__ bool next(int i, Unit& u) const { return S.next(i, u); }
    __device__ __forceinline__ const char* a_base(const Unit& u, int h) const { return (const char*)H2; }
    __device__ __forceinline__ const char* b_base(const Unit& u, int h) const { return (const char*)W1t + ((size_t)u.e * 4096 + (size_t)h * 2048 + (size_t)u.pn * 128) * K; }
    __device__ __forceinline__ unsigned gather(const Unit& u, int h, int R) const { return (unsigned)tokslot[u.pm * 256 + h * 128 + R] * (unsigned)K; }
    __device__ __forceinline__ void epi(const Acc& acc, const Unit& u, int wr, int wc, int fr, int fq) const {
        const int row0 = u.pm * 256 + wr * 64 + fr, colg = u.pn * 128 + wc * 32 + 8 * fq;
        const float* bp = b1 + (size_t)u.e * 4096 + colg;
        const f32x4 bg0 = *(const f32x4*)(bp), bg1 = *(const f32x4*)(bp + 4), bl0 = *(const f32x4*)(bp + 2048) + 1.0f, bl1 = *(const f32x4*)(bp + 2048 + 4) + 1.0f;
        float rsv[2][4];
#pragma unroll
        for (int ai = 0; ai < 2; ++ai)
#pragma unroll
            for (int m = 0; m < 4; ++m) rsv[ai][m] = rss[row0 + ai * 128 + m * 16];
#pragma unroll
        for (int ai = 0; ai < 2; ++ai)
#pragma unroll
            for (int m = 0; m < 4; ++m) {
                float o[8];
                const f32x2 rs2 = (f32x2){rsv[ai][m], rsv[ai][m]};
#pragma unroll
                for (int n = 0; n < 2; ++n)
#pragma unroll
                    for (int jp = 0; jp < 2; ++jp) {
                        const f32x4 ag = acc[ai][0][m][n], al = acc[ai][1][m][n], bg = n ? bg1 : bg0, bl = n ? bl1 : bl0;
                        f32x2 g = (f32x2){ag[2 * jp], ag[2 * jp + 1]} * rs2 + (f32x2){bg[2 * jp], bg[2 * jp + 1]};
                        f32x2 l1 = (f32x2){al[2 * jp], al[2 * jp + 1]} * rs2 + (f32x2){bl[2 * jp], bl[2 * jp + 1]};
                        g.x = fminf(g.x, 7.0f); g.y = fminf(g.y, 7.0f); l1.x = fminf(fmaxf(l1.x, -6.0f), 8.0f); l1.y = fminf(fmaxf(l1.y, -6.0f), 8.0f);
                        const f32x2 t = g * (-1.702f * 1.44269504f);
                        f32x2 d = (f32x2){__builtin_amdgcn_exp2f(t.x), __builtin_amdgcn_exp2f(t.y)} + 1.0f;
                        const f32x2 r = (f32x2){__builtin_amdgcn_rcpf(d.x), __builtin_amdgcn_rcpf(d.y)};
                        const f32x2 ov = g * r * l1;
                        o[n * 4 + 2 * jp] = ov.x; o[n * 4 + 2 * jp + 1] = ov.y; }
                v2u w; w.x = pk4_fp8(o[0], o[1], o[2], o[3]); w.y = pk4_fp8(o[4], o[5], o[6], o[7]);
                *(v2u*)(ACT + (size_t)(row0 + ai * 128 + m * 16) * DFF + colg) = w; }
    }
};
struct ProbMoe2 {
    static constexpr bool PERM = true, GATHER = false, FP8 = true, PERM64 = true;
    int K; pg8::MoeOrder<8> S; const unsigned char* ACT; const unsigned char* W2t; const float* b2; unsigned char* Y;
    __device__ __forceinline__ bool next(int i, Unit& u) const { return S.next(i, u); }
    __device__ __forceinline__ const char* a_base(const Unit& u, int h) const { return (const char*)ACT + (size_t)(u.pm * 256 + h * 128) * K; }
    __device__ __forceinline__ const char* b_base(const Unit& u, int h) const { return (const char*)W2t + ((size_t)u.e * 2048 + (size_t)u.pn * 256 + (size_t)h * 8) * K; }
    __device__ __forceinline__ void epi(const Acc& acc, const Unit& u, int wr, int wc, int fr, int fq) const {
        const int row0 = u.pm * 256 + wr * 64 + fr, col0 = u.pn * 256 + wc * 64 + 16 * fq;
        f32x4 bv[2][2];
#pragma unroll
        for (int bj = 0; bj < 2; ++bj)
#pragma unroll
            for (int n = 0; n < 2; ++n) bv[bj][n] = *(const f32x4*)(b2 + (size_t)u.e * D + col0 + bj * 8 + 4 * n);
#pragma unroll
        for (int ai = 0; ai < 2; ++ai)
#pragma unroll
            for (int m = 0; m < 4; ++m) { unsigned char* rowp = Y + (size_t)(row0 + ai * 128 + m * 16) * D + col0;
                const f32x4 v00 = acc[ai][0][m][0] + bv[0][0], v01 = acc[ai][0][m][1] + bv[0][1], v10 = acc[ai][1][m][0] + bv[1][0], v11 = acc[ai][1][m][1] + bv[1][1];
                v4u w; w.x = pk4_fp8(v00[0], v00[1], v00[2], v00[3]); w.y = pk4_fp8(v01[0], v01[1], v01[2], v01[3]); w.z = pk4_fp8(v10[0], v10[1], v10[2], v10[3]); w.w = pk4_fp8(v11[0], v11[1], v11[2], v11[3]);
                *(v4u*)rowp = w; }
    }
};

__device__ __forceinline__ void p0_transpose_item(const float* W, int K, int N, bf16* WT, LAS float* scr, int item, int lane) {
    const int nblk = N / 32, kb = item / nblk, nb = item % nblk, k0 = 64 * kb, n0 = 32 * nb;
#pragma unroll 8
    for (int i = 0; i < 32; ++i) { const int kk = 2 * i + (lane >> 5); scr[kk * 33 + (lane & 31)] = W[(size_t)(k0 + kk) * N + n0 + (lane & 31)]; }
    LDS_WAIT(); asm volatile("" ::: "memory");
    const int c = lane & 7;
#pragma unroll
    for (int j = 0; j < 4; ++j) { const int n = (lane >> 3) + 8 * j; const LAS float* s = scr + (8 * c) * 33 + n;
        v4u o; o.x = pk2(s[0 * 33], s[1 * 33]); o.y = pk2(s[2 * 33], s[3 * 33]); o.z = pk2(s[4 * 33], s[5 * 33]); o.w = pk2(s[6 * 33], s[7 * 33]);
        *(v4u*)(WT + (size_t)(n0 + n) * K + k0 + 8 * c) = o; }
    LDS_WAIT(); asm volatile("" ::: "memory");
}
struct Cvt64 { f32x4 v[16]; };
__device__ __forceinline__ void cvt64_load(Cvt64& q, const float* W, int N, int item, int lane) {
    const int nblk = N / 64, kb = item / nblk, nb = item % nblk, k0 = 64 * kb, n0 = 64 * nb, c4 = lane & 15, kr = lane >> 4;
#pragma unroll
    for (int i = 0; i < 16; ++i) q.v[i] = *(const f32x4*)(W + (size_t)(k0 + 4 * i + kr) * N + n0 + 4 * c4);
}
__device__ __forceinline__ void cvt64_store(const Cvt64& q, int K, int N, unsigned char* WT, LAS float* scr, int item, int lane, const float* kscale = nullptr) {
    const int nblk = N / 64, kb = item / nblk, nb = item % nblk, k0 = 64 * kb, n0 = 64 * nb, c4 = lane & 15, kr = lane >> 4;
#pragma unroll
    for (int i = 0; i < 16; ++i) { const int k = 4 * i + kr; const float sc = kscale ? 64.f * kscale[k0 + k] : 64.f;
        *(LAS f32x4*)(scr + k * 64 + 4 * (c4 ^ (k & 15) ^ ((k >> 4) << 2))) = q.v[i] * sc; }
    LDS_WAIT(); asm volatile("" ::: "memory");
    const int kc = lane & 3;
#pragma unroll
    for (int j = 0; j < 4; ++j) { const int n = (lane >> 2) + 16 * j; float f[16];
#pragma unroll
        for (int i = 0; i < 16; ++i) { const int k = 16 * kc + i; f[i] = scr[k * 64 + 4 * ((n >> 2) ^ (k & 15) ^ ((k >> 4) << 2)) + (n & 3)]; }
        v4u o; o.x = pk4_fp8(f[0], f[1], f[2], f[3]); o.y = pk4_fp8(f[4], f[5], f[6], f[7]); o.z = pk4_fp8(f[8], f[9], f[10], f[11]); o.w = pk4_fp8(f[12], f[13], f[14], f[15]);
        *(v4u*)(WT + (size_t)(n0 + n) * K + k0 + 16 * kc) = o; }
    LDS_WAIT(); asm volatile("" ::: "memory");
}
__device__ __forceinline__ void p0_transpose_item_fp8(const float* W, int K, int N, unsigned char* WT, LAS float* scr, int item, int lane) {
    const int nblk = N / 32, kb = item / nblk, nb = item % nblk, k0 = 64 * kb, n0 = 32 * nb;
#pragma unroll 8
    for (int i = 0; i < 32; ++i) { const int kk = 2 * i + (lane >> 5); scr[kk * 33 + (lane & 31)] = W[(size_t)(k0 + kk) * N + n0 + (lane & 31)]; }
    LDS_WAIT(); asm volatile("" ::: "memory");
    const int c = lane & 3;
#pragma unroll
    for (int j = 0; j < 2; ++j) { const int n = (lane >> 2) + 16 * j; const LAS float* s = scr + (16 * c) * 33 + n;
        v4u o; o.x = pk4_fp8(64.f * s[0 * 33], 64.f * s[1 * 33], 64.f * s[2 * 33], 64.f * s[3 * 33]); o.y = pk4_fp8(64.f * s[4 * 33], 64.f * s[5 * 33], 64.f * s[6 * 33], 64.f * s[7 * 33]);
        o.z = pk4_fp8(64.f * s[8 * 33], 64.f * s[9 * 33], 64.f * s[10 * 33], 64.f * s[11 * 33]); o.w = pk4_fp8(64.f * s[12 * 33], 64.f * s[13 * 33], 64.f * s[14 * 33], 64.f * s[15 * 33]);
        *(v4u*)(WT + (size_t)(n0 + n) * K + k0 + 16 * c) = o; }
    LDS_WAIT(); asm volatile("" ::: "memory");
}
__device__ __forceinline__ void rms_row_to_bf16(const float* xrow, const float* g, bf16* orow, int lane, unsigned* orow8 = nullptr) {
    const f32x4* xr = (const f32x4*)xrow + lane; const f32x4* gr = (const f32x4*)g + lane;
    f32x4 v[8]; float s = 0.f;
#pragma unroll
    for (int j = 0; j < 8; ++j) { v[j] = xr[64 * j]; s += (v[j].x * v[j].x + v[j].y * v[j].y) + (v[j].z * v[j].z + v[j].w * v[j].w); }
    const float rstd = 1.0f / sqrtf(wave_sum(s) * (1.f / D) + NORM_EPS);
    v2u* o8 = (v2u*)orow + lane;
#pragma unroll
    for (int j = 0; j < 8; ++j) { const f32x4 gg = gr[64 * j]; const float h0 = v[j].x * rstd * gg.x, h1 = v[j].y * rstd * gg.y, h2 = v[j].z * rstd * gg.z, h3 = v[j].w * rstd * gg.w;
        v2u w; w.x = pk2(h0, h1); w.y = pk2(h2, h3); o8[64 * j] = w; if (orow8) orow8[lane + 64 * j] = pk4_fp8(h0, h1, h2, h3); }
}

struct Args { const float* in[27]; float* out; unsigned char* ws; int ph_lo, ph_hi, li, pad; };
enum { I_X = 0, I_N1G, I_WIN, I_MU, I_W0, I_WDEC, I_A0, I_WICLR, I_WGATE, I_KK, I_KA, I_RK, I_LNG, I_LNB, I_BQKV, I_SINK, I_WUPR, I_WUPA, I_WOUT, I_N2G, I_WR, I_BR, I_W1, I_B1, I_W2, I_B2, I_NFG };
constexpr int NPHASE = 14;

__device__ __forceinline__ float dpp_xor1(float x) { return __builtin_bit_cast(float, __builtin_amdgcn_mov_dpp(__builtin_bit_cast(int, x), 0xB1, 0xF, 0xF, true)); }
__device__ __forceinline__ float dpp_xor2(float x) { return __builtin_bit_cast(float, __builtin_amdgcn_mov_dpp(__builtin_bit_cast(int, x), 0x4E, 0xF, 0xF, true)); }
__device__ __forceinline__ float dpp_hmir(float x) { return __builtin_bit_cast(float, __builtin_amdgcn_mov_dpp(__builtin_bit_cast(int, x), 0x141, 0xF, 0xF, true)); }
__device__ __forceinline__ float dpp_rmir(float x) { return __builtin_bit_cast(float, __builtin_amdgcn_mov_dpp(__builtin_bit_cast(int, x), 0x140, 0xF, 0xF, true)); }
__device__ __forceinline__ float red8(float x) { x += dpp_xor1(x); x += dpp_xor2(x); x += dpp_hmir(x); return x; }

__device__ __forceinline__ void cvt_experts(const Args& args, unsigned char* W1T, unsigned char* W2T, LAS float* scr, int lane, int first, int end, int stride) {
    constexpr int I_E1 = 32 * 64, I_E2 = 32 * 32;
#define CVT_SRC(it) ((it) < 32 * I_E1 ? args.in[I_W1] + (size_t)((it) / I_E1) * 2048 * 4096 : args.in[I_W2] + (size_t)(((it) - 32 * I_E1) / I_E2) * 2048 * 2048)
#define CVT_DST(it) ((it) < 32 * I_E1 ? W1T + (size_t)((it) / I_E1) * 4096 * 2048 : W2T + (size_t)(((it) - 32 * I_E1) / I_E2) * 2048 * 2048)
#define CVT_N(it) ((it) < 32 * I_E1 ? 4096 : 2048)
#define CVT_SUB(it) ((it) < 32 * I_E1 ? (it) % I_E1 : ((it) - 32 * I_E1) % I_E2)
    Cvt64 qa, qb; int ia = first, ib = first + stride;
    if (ia < end) cvt64_load(qa, CVT_SRC(ia), CVT_N(ia), CVT_SUB(ia), lane);
    while (ia < end) {
        if (ib < end) cvt64_load(qb, CVT_SRC(ib), CVT_N(ib), CVT_SUB(ib), lane);
        cvt64_store(qa, 2048, CVT_N(ia), CVT_DST(ia), scr, CVT_SUB(ia), lane, (ia < 32 * I_E1) ? args.in[I_N2G] : nullptr);
        ia = ib + stride;
        if (ib >= end) break;
        if (ia < end) cvt64_load(qa, CVT_SRC(ia), CVT_N(ia), CVT_SUB(ia), lane);
        cvt64_store(qb, 2048, CVT_N(ib), CVT_DST(ib), scr, CVT_SUB(ib), lane, (ib < 32 * I_E1) ? args.in[I_N2G] : nullptr);
        ib = ia + stride;
    }
#undef CVT_SRC
#undef CVT_DST
#undef CVT_N
#undef CVT_SUB
}

__global__ void __launch_bounds__(512, 2) fwd(Args args) {
    extern __shared__ __attribute__((aligned(16))) unsigned char lds_raw[];
    LAS unsigned char* lds = (LAS unsigned char*)lds_raw;
    volatile LAS unsigned* MISC = (volatile LAS unsigned*)(lds + MISC_OFF);
    LAS int* TAB = (LAS int*)(lds + TAB_OFF);
    const int tid = threadIdx.x, lane = tid & 63, wave = __builtin_amdgcn_readfirstlane(tid >> 6);
    const int G = gridDim.x, bx = blockIdx.x;
    const int vcu = (G % 8 == 0) ? (bx % 8) * (G / 8) + bx / 8 : bx;
    unsigned char* ws = args.ws;
    unsigned* ctl = (unsigned*)(ws + WS_CTL);
    for (int u = tid; u < 64; u += 512) MISC[u] = 0u;
    __syncthreads();
#if MK_N_LAUNCHES == 1
    XcdBarrier bar = xcd_barrier_post(ctl + CW_BAR + args.li * XCD_BAR_WORDS, MISC + 8);
#define GRID_BAR() xcd_barrier(bar)
#else
#define GRID_BAR() do {} while (0)
#endif
    const int lo = args.ph_lo, hi = args.ph_hi;
#define IN(k) (lo <= (k) && (k) < hi)
#define BOTH(k) (IN(k) && IN((k) + 1))
    const float* x = args.in[I_X];
    bf16* WinT = (bf16*)(ws + WS_WIN_T); bf16* WuprT = (bf16*)(ws + WS_WUPR_T); bf16* WupaT = (bf16*)(ws + WS_WUPA_T); bf16* WoutT = (bf16*)(ws + WS_WOUT_T);
    bf16* WdT = (bf16*)(ws + WS_WD_T); bf16* WiT = (bf16*)(ws + WS_WI_T); bf16* WgT = (bf16*)(ws + WS_WG_T);
    unsigned char* W1T = ws + WS_W1_T; unsigned char* W2T = ws + WS_W2_T;
    unsigned char* H8 = ws + WS_H;
    bf16* Hb = (bf16*)(ws + WS_H); bf16* Z = (bf16*)(ws + WS_Z);
    unsigned char* scb = ws + WS_SCAN;
    bf16* S_R = (bf16*)(scb + SC_R); bf16* S_KF = (bf16*)(scb + SC_KF); bf16* S_V = (bf16*)(scb + SC_V); bf16* S_AN = (bf16*)(scb + SC_AN); bf16* S_BN = (bf16*)(scb + SC_BN); bf16* S_G = (bf16*)(scb + SC_G);
    float* S_LW = (float*)(scb + SC_LW); bf16* S_QR = (bf16*)(scb + SC_QR); float* S_YL = (float*)(scb + SC_YL); bf16* S_E = (bf16*)(scb + SC_E); float* S_HP = (float*)(scb + SC_HP);
    bf16* PST = (bf16*)(ws + WS_PST); float* GAMg = (float*)(ws + WS_GAM); float* BDg = (float*)(ws + WS_BD);
    bf16* YR = (bf16*)(ws + WS_YR); bf16* YA = (bf16*)(ws + WS_YA); bf16* T1 = (bf16*)(ws + WS_T1); bf16* MG = (bf16*)(ws + WS_MG);
    unsigned char* ACT = ws + WS_ACT; unsigned char* Yb = ws + WS_Y;
    int* topi = (int*)(ws + WS_TOPI); float* topg = (float*)(ws + WS_TOPG); int* slotof = (int*)(ws + WS_SLOT);
    int* tokslot = (int*)(ctl + CW_TOKSLOT);
    bf16* X1 = (bf16*)(ws + WS_X1); bf16* WrS = (bf16*)(ws + WS_WRT); float* rss = (float*)(ctl + CW_RSS);
    float* rstd_tok = (float*)(ws + WS_BD);
    unsigned* cntw = ctl + CW_CNT + args.li * 256;
    const int gw = vcu * 8 + wave, NGW = G * 8;
    const bool split = (G % 16 == 0);
    const int role = split ? ((bx >> 3) & 1) : 0, rank = split ? ((bx >> 4) * 8 + (bx & 7)) : bx, GG = split ? G / 2 : G;
    const int cfirst = (split ? rank : vcu) * 8 + wave, cstride = GG * 8;
    constexpr int NEI = 32 * 32 * 64 + 32 * 32 * 32, NEI1 = 92 * 1024, NEI0 = 26 * 1024;

    if (IN(0)) {
        LAS float* scr = (LAS float*)(lds + wave * 16384);
        constexpr int I_IN = 32 * 152, I_UP = 16 * 64, I_OUT = 32 * 64, I_E1 = 32 * 64, I_E2 = 32 * 32;
        constexpr int NITEMS = I_IN + 2 * I_UP + I_OUT + 128;
        if (split && role == 1) cvt_experts(args, W1T, W2T, scr, lane, cfirst, NEI0, cstride);
        else {
        const int gwp = split ? cfirst : gw, NGWp = split ? cstride : NGW;
        for (int it = gwp; it < NITEMS; it += NGWp) {
            int r = it;
            if (r < I_IN) { p0_transpose_item(args.in[I_WIN], 2048, IN_COLS, WinT, scr, (r / 152) * 280 + (r % 152), lane); continue; } r -= I_IN;
            if (r < I_UP) { if (r < 16 * 32) { Cvt64 q; cvt64_load(q, args.in[I_WUPR], 2048, r, lane); cvt64_store(q, 1024, 2048, (unsigned char*)WuprT, scr, r, lane); } continue; } r -= I_UP;
            if (r < I_UP) { if (r < 16 * 32) { Cvt64 q; cvt64_load(q, args.in[I_WUPA], 2048, r, lane); cvt64_store(q, 1024, 2048, (unsigned char*)WupaT, scr, r, lane); } continue; } r -= I_UP;
            if (r < I_OUT) { if (r < 32 * 32) { Cvt64 q; cvt64_load(q, args.in[I_WOUT], 2048, r, lane); cvt64_store(q, 2048, 2048, (unsigned char*)WoutT, scr, r, lane); } continue; } r -= I_OUT;
            if (r < 32) { p0_transpose_item(args.in[I_WDEC], 64, 1024, WdT, scr, r, lane); continue; } r -= 32;
            if (r < 32) { p0_transpose_item(args.in[I_WICLR], 64, 1024, WiT, scr, r, lane); continue; } r -= 32;
            p0_transpose_item(args.in[I_WGATE], 128, 1024, WgT, scr, r, lane);
        }
        for (int it = gwp; it < 32 * 64; it += NGWp) { Cvt64 q; const int item = (it >> 6) * (IN_COLS / 64) + (it & 63);
            cvt64_load(q, args.in[I_WIN] + ZC_GR, IN_COLS, item, lane); cvt64_store(q, 2048, IN_COLS, ws + WS_WING, scr, item, lane); }
        for (int i = rank * 512 + tid; i < 32 * 2048; i += GG * 512) { const int e = i >> 11, k = i & 2047; const float w = args.in[I_N2G][k] * args.in[I_WR][k * 32 + e];
            const unsigned h = f2bf(w); const float r1 = w - __builtin_bit_cast(float, h << 16); const unsigned m = f2bf(r1); const float r2 = r1 - __builtin_bit_cast(float, m << 16);
            WrS[i] = (bf16)h; WrS[65536 + i] = (bf16)m; WrS[131072 + i] = (bf16)f2bf(r2); }
        for (int m = gwp; m < NT; m += NGWp) rms_row_to_bf16(x + (size_t)m * D, args.in[I_N1G], Hb + (size_t)m * D, lane, (unsigned*)(ws + WS_H1F + (size_t)m * D));
        }
        if (BOTH(0)) GRID_BAR();
    }
    if (IN(1)) {
        const int nei1 = split ? NEI1 : NEI, cbeg = split ? NEI0 : 0;
        if (!split || role == 1) cvt_experts(args, W1T, W2T, (LAS float*)(lds + wave * 16384), lane, cbeg + cfirst, nei1, cstride);
        if (!split || role == 1) { __syncthreads(); ProbInG Pg; Pg.K = 2048; Pg.S.init(NT, IN_COLS - ZC_GR, GG, rank, 0, 0); Pg.A = ws + WS_H1F; Pg.Bt = ws + WS_WING; Pg.Z = Z; pg8::gemm_phase(lds, Pg); }
        constexpr int NB0 = 18 * 128;
        if (split && role == 1) { ProbIn P; P.K = 2048; P.S.init(NT, ZC_GR, GG, rank); P.S.first = NB0; P.S.count = 2432 - NB0; P.A = Hb; P.Bt = WinT; P.Z = Z; P.bqkv = args.in[I_BQKV]; pg8::gemm_phase(lds, P); }
        if (!split || role == 0) { ProbIn P; P.K = 2048; P.S.init(NT, ZC_GR, GG, rank); if (split) { P.S.first = 0; P.S.count = NB0; } P.A = Hb; P.Bt = WinT; P.Z = Z; P.bqkv = args.in[I_BQKV]; pg8::gemm_phase(lds, P);
            if (split) { __syncthreads(); cvt_experts(args, W1T, W2T, (LAS float*)(lds + wave * 16384), lane, NEI1 + cfirst, NEI, cstride); } }
        if (BOTH(1)) GRID_BAR();
    }
    if (IN(2)) {
        {
            constexpr int XS = 528;
            LAS unsigned char* XL = lds; LAS float* NRM = (LAS float*)(lds + 64 * XS);
            LAS float* PRM = (LAS float*)(lds + 40960);
            for (int idx = tid; idx < 7 * 1024; idx += 512) { const int ar = idx >> 10, c = idx & 1023;
                PRM[idx] = ar == 0 ? args.in[I_W0][c] : ar == 1 ? args.in[I_A0][c] : ar == 2 ? args.in[I_KK][c] : ar == 3 ? args.in[I_KA][c] : ar == 4 ? args.in[I_MU][ZC_R + c] : ar == 5 ? args.in[I_MU][ZC_K + c] : args.in[I_MU][ZC_V + c]; }
            const float* mu = args.in[I_MU]; const float* kkp = args.in[I_KK];
            const int fr = lane & 15, fq = lane >> 4;
            for (int un = bx; un < NT / 64; un += G) {
                const size_t t0 = (size_t)un * 64;
                __syncthreads();
#pragma unroll
                for (int i = 0; i < 4; ++i) {
                    const int idx = tid + 512 * i, tok = idx >> 5, c8 = idx & 31, col = ZC_LORA + 8 * c8; const size_t t = t0 + tok;
                    const v4u cw = *(const v4u*)(Z + t * IN_COLS + col); v4u pw = (v4u){0u, 0u, 0u, 0u}; if (t % SEQ != 0) pw = *(const v4u*)(Z + (t - 1) * IN_COLS + col);
                    const f32x4 m0 = *(const f32x4*)(mu + col), m1 = *(const f32x4*)(mu + col + 4);
                    float xv[8]; const unsigned cu[4] = {cw.x, cw.y, cw.z, cw.w}, pu[4] = {pw.x, pw.y, pw.z, pw.w};
#pragma unroll
                    for (int j = 0; j < 4; ++j) { const float ml = j < 2 ? m0[2 * j] : m1[2 * j - 4], mh = j < 2 ? m0[2 * j + 1] : m1[2 * j - 3];
                        xv[2 * j] = bflo(cu[j]) + (bflo(pu[j]) - bflo(cu[j])) * ml; xv[2 * j + 1] = bfhi(cu[j]) + (bfhi(pu[j]) - bfhi(cu[j])) * mh; }
                    if (c8 < 8) {
#pragma unroll
                        for (int j = 0; j < 8; ++j) xv[j] = 1.0f - 2.0f * __builtin_amdgcn_rcpf(1.0f + __expf(2.0f * xv[j])); }
                    else if (c8 >= 16) {
#pragma unroll
                        for (int j = 0; j < 8; ++j) xv[j] = sigmoidf_(xv[j]); }
                    *(LAS v4u*)(XL + tok * XS + c8 * 16) = (v4u){pk2(xv[0], xv[1]), pk2(xv[2], xv[3]), pk2(xv[4], xv[5]), pk2(xv[6], xv[7])};
                }
#pragma unroll 4
                for (int i = 0; i < 16; ++i) {
                    const int pr = (tid >> 3) + 64 * i, tok = pr >> 4, hd = pr & 15, ch = hd * 64 + 8 * (tid & 7); const size_t t = t0 + tok;
                    const v4u cw = *(const v4u*)(Z + t * IN_COLS + ZC_K + ch); v4u pw = (v4u){0u, 0u, 0u, 0u}; if (t % SEQ != 0) pw = *(const v4u*)(Z + (t - 1) * IN_COLS + ZC_K + ch);
                    const LAS float* pp = PRM + ch;
                    const f32x4 m0 = *(const LAS f32x4*)(pp + 5120), m1 = *(const LAS f32x4*)(pp + 5124), k0 = *(const LAS f32x4*)(pp + 2048), k1 = *(const LAS f32x4*)(pp + 2052);
                    const unsigned cu[4] = {cw.x, cw.y, cw.z, cw.w}, pu[4] = {pw.x, pw.y, pw.z, pw.w};
                    float ss = 0.f;
#pragma unroll
                    for (int j = 0; j < 4; ++j) { const float ml = j < 2 ? m0[2 * j] : m1[2 * j - 4], mh = j < 2 ? m0[2 * j + 1] : m1[2 * j - 3], kl = j < 2 ? k0[2 * j] : k1[2 * j - 4], kh = j < 2 ? k0[2 * j + 1] : k1[2 * j - 3];
                        const float a = (bflo(cu[j]) + (bflo(pu[j]) - bflo(cu[j])) * ml) * kl, bq = (bfhi(cu[j]) + (bfhi(pu[j]) - bfhi(cu[j])) * mh) * kh; ss += a * a + bq * bq; }
                    ss = red8(ss);
                    if ((tid & 7) == 0) NRM[tok * 16 + hd] = 1.0f / fmaxf(sqrtf(ss), 1e-12f);
                }
                __syncthreads();
                for (int cp = 0; cp < 4; ++cp) {
                    const int c0 = 128 * wave + 32 * cp, hd = c0 >> 6, ch8 = c0 + 8 * fq;
                    bf16x8 wd[2][2], wi[2][2], wg[2][4];
#pragma unroll
                    for (int ab = 0; ab < 2; ++ab) { const int chr = c0 + 8 * (fr >> 2) + 4 * ab + (fr & 3);
#pragma unroll
                        for (int ks = 0; ks < 2; ++ks) { wd[ab][ks] = *(const bf16x8*)(WdT + chr * 64 + 32 * ks + 8 * fq); wi[ab][ks] = *(const bf16x8*)(WiT + chr * 64 + 32 * ks + 8 * fq); }
#pragma unroll
                        for (int ks = 0; ks < 4; ++ks) wg[ab][ks] = *(const bf16x8*)(WgT + chr * 128 + 32 * ks + 8 * fq); }
                    v4u zpf[2][4];
#define PREP_ZLOAD(q, tt_) do { const size_t t_ = t0 + 16 * (tt_) + fr; const bf16* zr_ = Z + t_ * IN_COLS + ch8; \
                        q[0] = *(const v4u*)(zr_ + ZC_K); q[1] = *(const v4u*)(zr_ + ZC_V); q[2] = (v4u){0u, 0u, 0u, 0u}; q[3] = q[2]; \
                        if (t_ % SEQ != 0) { q[2] = *(const v4u*)(zr_ - IN_COLS + ZC_K); q[3] = *(const v4u*)(zr_ - IN_COLS + ZC_V); } } while (0)
                    PREP_ZLOAD(zpf[0], 0);
#pragma unroll
                    for (int tt = 0; tt < 4; ++tt) {
                        asm volatile("" ::: "memory");
                        if (tt + 1 < 4) PREP_ZLOAD(zpf[(tt + 1) & 1], tt + 1);
                        asm volatile("" ::: "memory");
                        const int tok = 16 * tt + fr; const size_t t = t0 + tok;
                        f32x4 dw[2], da[2], dg[2];
#pragma unroll
                        for (int ab = 0; ab < 2; ++ab) { dw[ab] = (f32x4){0.f, 0.f, 0.f, 0.f}; da[ab] = dw[ab]; dg[ab] = dw[ab]; }
#pragma unroll
                        for (int ks = 0; ks < 8; ++ks) { const bf16x8 xb = *(const LAS bf16x8*)(XL + tok * XS + (32 * ks + 8 * fq) * 2);
#pragma unroll
                            for (int ab = 0; ab < 2; ++ab) {
                                if (ks < 2) dw[ab] = __builtin_amdgcn_mfma_f32_16x16x32_bf16(wd[ab][ks], xb, dw[ab], 0, 0, 0);
                                else if (ks < 4) da[ab] = __builtin_amdgcn_mfma_f32_16x16x32_bf16(wi[ab][ks - 2], xb, da[ab], 0, 0, 0);
                                else dg[ab] = __builtin_amdgcn_mfma_f32_16x16x32_bf16(wg[ab][ks - 4], xb, dg[ab], 0, 0, 0); } }
                        const v4u ck4 = zpf[tt & 1][0], cv4 = zpf[tt & 1][1], pk4 = zpf[tt & 1][2], pv4 = zpf[tt & 1][3];
                        const float inrm = NRM[tok * 16 + hd];
                        unsigned q_kf[4], q_v[4], q_an[4], q_bn[4], q_g[4]; float o_lw[8];
#pragma unroll
                        for (int ab = 0; ab < 2; ++ab) {
                            asm volatile("" ::: "memory");
                            const LAS float* pp = PRM + ch8 + 4 * ab;
                            const f32x4 pw0 = *(const LAS f32x4*)(pp), pa0 = *(const LAS f32x4*)(pp + 1024), pkk = *(const LAS f32x4*)(pp + 2048), pka = *(const LAS f32x4*)(pp + 3072),
                                        pmk = *(const LAS f32x4*)(pp + 5120), pmv = *(const LAS f32x4*)(pp + 6144);
                            const unsigned cku[2] = {ab ? ck4.z : ck4.x, ab ? ck4.w : ck4.y}, cvu[2] = {ab ? cv4.z : cv4.x, ab ? cv4.w : cv4.y}, pku[2] = {ab ? pk4.z : pk4.x, ab ? pk4.w : pk4.y}, pvu[2] = {ab ? pv4.z : pv4.x, ab ? pv4.w : pv4.y};
                            float e_kf[4], e_v[4], e_an[4], e_bn[4];
#pragma unroll
                            for (int j = 0; j < 4; ++j) { const int w = j >> 1; const bool hi = j & 1;
                                const float kc = hi ? bfhi(cku[w]) : bflo(cku[w]), kp2 = hi ? bfhi(pku[w]) : bflo(pku[w]), vc = hi ? bfhi(cvu[w]) : bflo(cvu[w]), vp2 = hi ? bfhi(pvu[w]) : bflo(pvu[w]);
                                const float kx = kc + (kp2 - kc) * pmk[j];
                                const float a = sigmoidf_(pa0[j] + da[ab][j]); const float kk = kx * pkk[j] * inrm;
                                o_lw[4 * ab + j] = -0.60653066f * sigmoidf_(pw0[j] + dw[ab][j]);
                                e_kf[j] = kx * (1.0f + (a - 1.0f) * pka[j]); e_v[j] = vc + (vp2 - vc) * pmv[j]; e_an[j] = -kk; e_bn[j] = kk * a; }
                            q_kf[2 * ab] = pk2(e_kf[0], e_kf[1]); q_kf[2 * ab + 1] = pk2(e_kf[2], e_kf[3]);
                            q_v[2 * ab] = pk2(e_v[0], e_v[1]); q_v[2 * ab + 1] = pk2(e_v[2], e_v[3]); q_an[2 * ab] = pk2(e_an[0], e_an[1]); q_an[2 * ab + 1] = pk2(e_an[2], e_an[3]);
                            q_bn[2 * ab] = pk2(e_bn[0], e_bn[1]); q_bn[2 * ab + 1] = pk2(e_bn[2], e_bn[3]); q_g[2 * ab] = pk2(dg[ab][0], dg[ab][1]); q_g[2 * ab + 1] = pk2(dg[ab][2], dg[ab][3]);
                        }
                        const size_t o = t * C + ch8;
                        *(v4u*)(S_KF + o) = (v4u){q_kf[0], q_kf[1], q_kf[2], q_kf[3]}; *(v4u*)(S_V + o) = (v4u){q_v[0], q_v[1], q_v[2], q_v[3]};
                        *(v4u*)(S_AN + o) = (v4u){q_an[0], q_an[1], q_an[2], q_an[3]}; *(v4u*)(S_BN + o) = (v4u){q_bn[0], q_bn[1], q_bn[2], q_bn[3]}; *(v4u*)(S_G + o) = (v4u){q_g[0], q_g[1], q_g[2], q_g[3]};
                        *(v4u*)((bf16*)S_LW + o) = (v4u){pk2(o_lw[0], o_lw[1]), pk2(o_lw[2], o_lw[3]), pk2(o_lw[4], o_lw[5]), pk2(o_lw[6], o_lw[7])};
                    }
                }
            }
        }
#undef PREP_ZLOAD
        if (BOTH(2)) GRID_BAR();
    }
    if (IN(3)) {
        constexpr int MS = 144;
        constexpr int LA_R = 0, LA_B = 9216, LA_AT = 18432, LA_BT = 27648, LA_ARB = 36864, LA_AKVT = 46080,
                      LA_AABH = 55296  , LA_DG = 64512  , LA_DH = 69632  ,
                      LA_GAM = 72704, LA_A = 73728, LA_K = 82944, LA_KT = 92160, LA_VT = 101376, LA_AAK = 110592, LA_ARK = 119808, LA_SEG = LA_AABH;
        const int rb = wave >> 1, cb0 = 2 * (wave & 1);
#define FRAG(off, row, kb) (*(const LAS bf16x8*)(lds + (off) + (row) * MS + (kb)))
#define PROD2(acc, XO, YO) do { _Pragma("unroll") for (int ks = 0; ks < 2; ++ks) { const bf16x8 a_ = FRAG(XO, 16 * rb + fr, 16 * fq + 64 * ks); \
            _Pragma("unroll") for (int n = 0; n < 2; ++n) { const bf16x8 b_ = FRAG(YO, 16 * (cb0 + n) + fr, 16 * fq + 64 * ks); acc[n] = __builtin_amdgcn_mfma_f32_16x16x32_bf16(a_, b_, acc[n], 0, 0, 0); } } } while (0)
        const float* rkp = args.in[I_RK];
        bf16 pr_[9], pk_[8], pv_[8], pa_[8], pb_[8], pl_[8];
        if (bx < 512 * 16) { const size_t g0 = ((size_t)(bx >> 4) * 64 + 8 * wave) * C + (bx & 15) * 64 + lane;
            { const size_t tr0 = (size_t)(bx >> 4) * 64 + 8 * wave; const int cz = ZC_R + (bx & 15) * 64 + lane;
#pragma unroll
              for (int j = 0; j < 9; ++j) pr_[j] = ((tr0 + j) % SEQ == 0 && j == 0) ? (bf16)0 : Z[(tr0 + j - 1) * IN_COLS + cz]; }
#pragma unroll
            for (int j = 0; j < 8; ++j) { const size_t o = g0 + (size_t)j * C; pk_[j] = S_KF[o]; pv_[j] = S_V[o]; pa_[j] = S_AN[o]; pb_[j] = S_BN[o]; pl_[j] = ((const bf16*)S_LW)[o]; } }
        for (int un = bx; un < 512 * 16; un += G) {
            const int h = un & 15, tb = un >> 4; const size_t t0 = (size_t)tb * 64;
            int ln = lane; asm volatile("" : "+v"(ln));
            const int fr = ln & 15, fq = ln >> 4;
            __syncthreads();
            {
                float r8[8], k8[8], v8[8], a8[8], b8[8], lw8[8], cs[8];
                const float mur_ = args.in[I_MU][ZC_R + h * 64 + ln], rkv = rkp[h * 64 + ln];
#pragma unroll
                for (int j = 0; j < 8; ++j) { const float rc_ = bf1(pr_[j + 1]), rp_ = bf1(pr_[j]); r8[j] = rc_ + (rp_ - rc_) * mur_; k8[j] = bf1(pk_[j]); v8[j] = bf1(pv_[j]); a8[j] = bf1(pa_[j]); b8[j] = bf1(pb_[j]); lw8[j] = bf1(pl_[j]); }
                {
                    const int un2 = (un + G < 512 * 16) ? un + G : un;
                    const size_t g2 = ((size_t)(un2 >> 4) * 64 + 8 * wave) * C + (un2 & 15) * 64 + ln;
                    { const size_t tr2 = (size_t)(un2 >> 4) * 64 + 8 * wave; const int cz2 = ZC_R + (un2 & 15) * 64 + ln;
#pragma unroll
                      for (int j = 0; j < 9; ++j) pr_[j] = ((tr2 + j) % SEQ == 0 && j == 0) ? (bf16)0 : Z[(tr2 + j - 1) * IN_COLS + cz2]; }
#pragma unroll
                    for (int j = 0; j < 8; ++j) { const size_t o = g2 + (size_t)j * C; pk_[j] = S_KF[o]; pv_[j] = S_V[o]; pa_[j] = S_AN[o]; pb_[j] = S_BN[o]; pl_[j] = ((const bf16*)S_LW)[o]; }
                }
                cs[0] = lw8[0];
#pragma unroll
                for (int j = 1; j < 8; ++j) cs[j] = cs[j - 1] + lw8[j];
                ((LAS float*)(lds + LA_SEG))[wave * 64 + ln] = cs[7];
                {
                    float x4[4], x2[2], x1;
                    const bool b0 = ln & 1, b1 = ln & 2, b2 = ln & 4;
#pragma unroll
                    for (int i = 0; i < 4; ++i) { const float e = r8[2 * i] * k8[2 * i] * rkv, o = r8[2 * i + 1] * k8[2 * i + 1] * rkv; x4[i] = (b0 ? o : e) + dpp_xor1(b0 ? e : o); }
#pragma unroll
                    for (int i = 0; i < 2; ++i) { const float e = x4[2 * i], o = x4[2 * i + 1]; x2[i] = (b1 ? o : e) + dpp_xor2(b1 ? e : o); }
                    { const float e = x2[0], o = x2[1]; x1 = (b2 ? o : e) + __shfl_xor(b2 ? e : o, 4); }
                    x1 += __shfl_xor(x1, 8); x1 += __shfl_xor(x1, 16); x1 += __shfl_xor(x1, 32);
                    if (ln < 8) BDg[(t0 + 8 * wave + ln) * 16 + h] = x1;
                }
                __syncthreads();
                float pre = 0.f, tot = 0.f;
#pragma unroll
                for (int s = 0; s < 8; ++s) { const float xx = ((LAS float*)(lds + LA_SEG))[s * 64 + ln]; tot += xx; pre += (s < wave) ? xx : 0.f; }
                unsigned pa[4], pb[4], pk[4], pv[4];
#pragma unroll
                for (int j2 = 0; j2 < 4; ++j2) {
                    float Rf[2], Af[2], Bf[2], Kf[2];
#pragma unroll
                    for (int u = 0; u < 2; ++u) { const int j = 2 * j2 + u; const float cum = pre + cs[j], ec = __expf(cum), en = __expf(-cum), ep = __expf(cum - lw8[j]);
                        Rf[u] = r8[j] * ec; Af[u] = a8[j] * ep; Bf[u] = b8[j] * en; Kf[u] = k8[j] * en; }
                    const unsigned Rw = pk2(Rf[0], Rf[1]), Aw = pk2(Af[0], Af[1]), Bw = pk2(Bf[0], Bf[1]), Kw = pk2(Kf[0], Kf[1]);
                    pa[j2] = Aw; pb[j2] = Bw; pk[j2] = Kw; pv[j2] = (__builtin_bit_cast(unsigned, v8[2 * j2]) >> 16) | (__builtin_bit_cast(unsigned, v8[2 * j2 + 1]) & 0xffff0000u);
                    const int t = 8 * wave + 2 * j2;
                    *(LAS bf16*)(lds + LA_R + t * MS + ln * 2) = (bf16)(Rw & 0xffffu); *(LAS bf16*)(lds + LA_R + (t + 1) * MS + ln * 2) = (bf16)(Rw >> 16);
                    *(LAS bf16*)(lds + LA_A + t * MS + ln * 2) = (bf16)(Aw & 0xffffu); *(LAS bf16*)(lds + LA_A + (t + 1) * MS + ln * 2) = (bf16)(Aw >> 16);
                    *(LAS bf16*)(lds + LA_B + t * MS + ln * 2) = (bf16)(Bw & 0xffffu); *(LAS bf16*)(lds + LA_B + (t + 1) * MS + ln * 2) = (bf16)(Bw >> 16);
                    *(LAS bf16*)(lds + LA_K + t * MS + ln * 2) = (bf16)(Kw & 0xffffu); *(LAS bf16*)(lds + LA_K + (t + 1) * MS + ln * 2) = (bf16)(Kw >> 16);
                }
                *(LAS v4u*)(lds + LA_AT + ln * MS + wave * 16) = (v4u){pa[0], pa[1], pa[2], pa[3]};
                *(LAS v4u*)(lds + LA_BT + ln * MS + wave * 16) = (v4u){pb[0], pb[1], pb[2], pb[3]};
                *(LAS v4u*)(lds + LA_KT + ln * MS + wave * 16) = (v4u){pk[0], pk[1], pk[2], pk[3]};
                *(LAS v4u*)(lds + LA_VT + ln * MS + wave * 16) = (v4u){pv[0], pv[1], pv[2], pv[3]};
                if (wave == 0) { const float gl = __expf(tot); ((LAS float*)(lds + LA_GAM))[ln] = gl; GAMg[(size_t)un * 64 + ln] = gl; }
            }
            __syncthreads();
            {
                f32x4 cab[2], cak[2], crb[2], crk[2];
#pragma unroll
                for (int n = 0; n < 2; ++n) { cab[n] = (f32x4){0.f, 0.f, 0.f, 0.f}; cak[n] = cab[n]; crb[n] = cab[n]; crk[n] = cab[n]; }
#pragma unroll
                for (int ks = 0; ks < 2; ++ks) { const bf16x8 aA = FRAG(LA_A, 16 * rb + fr, 16 * fq + 64 * ks), aR = FRAG(LA_R, 16 * rb + fr, 16 * fq + 64 * ks);
#pragma unroll
                    for (int n = 0; n < 2; ++n) { const bf16x8 bB = FRAG(LA_B, 16 * (cb0 + n) + fr, 16 * fq + 64 * ks), bK = FRAG(LA_K, 16 * (cb0 + n) + fr, 16 * fq + 64 * ks);
                        cab[n] = __builtin_amdgcn_mfma_f32_16x16x32_bf16(aA, bB, cab[n], 0, 0, 0); cak[n] = __builtin_amdgcn_mfma_f32_16x16x32_bf16(aA, bK, cak[n], 0, 0, 0);
                        crb[n] = __builtin_amdgcn_mfma_f32_16x16x32_bf16(aR, bB, crb[n], 0, 0, 0); crk[n] = __builtin_amdgcn_mfma_f32_16x16x32_bf16(aR, bK, crk[n], 0, 0, 0); } }
#pragma unroll
                for (int n = 0; n < 2; ++n)
#pragma unroll
                    for (int rg = 0; rg < 4; ++rg) { const int t = 16 * rb + 4 * fq + rg, s = 16 * (cb0 + n) + fr;
                        const float vab = (s < t) ? cab[n][rg] : 0.f;
                        *(LAS bf16*)(lds + LA_AABH + t * MS + s * 2) = (bf16)f2bf(vab);
                        if (rb == cb0 + n) ((LAS float*)(lds + LA_DG))[rb * 320 + (4 * fq + rg) * 20 + fr] = vab;
                        *(LAS bf16*)(lds + LA_AAK + t * MS + s * 2) = (bf16)((s < t) ? f2bf(cak[n][rg]) : 0u);
                        *(LAS bf16*)(lds + LA_ARB + t * MS + s * 2) = (bf16)((s <= t) ? f2bf(crb[n][rg]) : 0u);
                        *(LAS bf16*)(lds + LA_ARK + t * MS + s * 2) = (bf16)((s <= t) ? f2bf(crk[n][rg]) : 0u); }
            }
            __syncthreads();
            f32x4 accY[2], accH[2];
            {
                f32x4 ckv[2];
#pragma unroll
                for (int n = 0; n < 2; ++n) { ckv[n] = (f32x4){0.f, 0.f, 0.f, 0.f}; accY[n] = ckv[n]; accH[n] = ckv[n]; }
                PROD2(ckv, LA_AAK, LA_VT); PROD2(accY, LA_ARK, LA_VT); PROD2(accH, LA_KT, LA_VT);
#pragma unroll
                for (int n = 0; n < 2; ++n) { v2u w; w.x = pk2(ckv[n][0], ckv[n][1]); w.y = pk2(ckv[n][2], ckv[n][3]);
                    *(LAS v2u*)(lds + LA_AKVT + (16 * (cb0 + n) + fr) * MS + (16 * rb + 4 * fq) * 2) = w; }
                if (wave == 7) {
                    const int blk = ln >> 4, cc = ln & 15; const LAS float* Ad = (const LAS float*)(lds + LA_DG) + blk * 320;
                    float wc[16];
#pragma unroll
                    for (int t = 0; t < 16; ++t) { float a_ = (t == cc) ? 1.0f : 0.0f;
#pragma unroll
                        for (int s4 = 0; s4 < (t + 3) / 4; ++s4) { const f32x4 av = *(const LAS f32x4*)(Ad + t * 20 + s4 * 4);
#pragma unroll
                            for (int q = 0; q < 4; ++q) if (s4 * 4 + q < t) a_ += av[q] * wc[s4 * 4 + q]; }
                        wc[t] = a_; }
#pragma unroll
                    for (int t = 0; t < 16; ++t) *(LAS bf16*)(lds + LA_DH + blk * 768 + t * 48 + cc * 2) = (bf16)f2bf(wc[t]);
                }
            }
            __syncthreads();
            {
                LAS unsigned char* xb = lds + (wave < 4 ? LA_AT + 16 * wave * MS : LA_AKVT + 16 * (wave - 4) * MS);
                const bf16x8 zf = (bf16x8){0, 0, 0, 0, 0, 0, 0, 0};
#pragma unroll
                for (int i = 0; i < 4; ++i) {
                    LAS unsigned char* zp = xb + fr * MS + (16 * i + 4 * fq) * 2;
                    const v2u xw = *(const LAS v2u*)zp;
                    f32x4 y = (f32x4){bflo(xw.x), bfhi(xw.x), bflo(xw.y), bfhi(xw.y)};
#pragma unroll
                    for (int ks = 0; ks < (i + 1) / 2; ++ks) {
                        const bool live = (8 * fq + 32 * ks) < 16 * i;
                        bf16x8 a_ = FRAG(LA_AABH, 16 * i + fr, 16 * fq + 64 * ks), b_ = *(const LAS bf16x8*)(xb + fr * MS + 16 * fq + 64 * ks);
                        if (!live) { a_ = zf; b_ = zf; }
                        y = __builtin_amdgcn_mfma_f32_16x16x32_bf16(a_, b_, y, 0, 0, 0);
                    }
                    v2u yw; yw.x = pk2(y[0], y[1]); yw.y = pk2(y[2], y[3]);
                    const v2u dw = *(const LAS v2u*)(lds + LA_DH + i * 768 + fr * 48 + fq * 8);
                    const f32x4 z = __builtin_amdgcn_mfma_f32_16x16x16bf16_1k(__builtin_bit_cast(s16x4, dw), __builtin_bit_cast(s16x4, yw), (f32x4){0.f, 0.f, 0.f, 0.f}, 0, 0, 0);
                    v2u zw; zw.x = pk2(z[0], z[1]); zw.y = pk2(z[2], z[3]);
                    *(LAS v2u*)zp = zw;
                    asm volatile("s_waitcnt lgkmcnt(0)" ::: "memory");
                }
            }
            __syncthreads();
            {
                PROD2(accY, LA_ARB, LA_AKVT);
                PROD2(accH, LA_BT, LA_AKVT);
                f32x4 cE[2], cQ[2];
#pragma unroll
                for (int n = 0; n < 2; ++n) { cE[n] = (f32x4){0.f, 0.f, 0.f, 0.f};
                    const v2u rr = *(const LAS v2u*)(lds + LA_R + (16 * (cb0 + n) + fr) * MS + (16 * rb + 4 * fq) * 2);
                    cQ[n] = (f32x4){bflo(rr.x), bfhi(rr.x), bflo(rr.y), bfhi(rr.y)}; }
                PROD2(cE, LA_AT, LA_BT);
                PROD2(cQ, LA_AT, LA_ARB);
                const size_t ib = (size_t)un * 4096;
#pragma unroll
                for (int n = 0; n < 2; ++n) {
                    { v2u wy; wy.x = pk2(accY[n][0], accY[n][1]); wy.y = pk2(accY[n][2], accY[n][3]); *(v2u*)((bf16*)S_YL + ib + (size_t)(((rb * 4 + cb0 + n) * 64 + ln) * 4)) = wy; }
                    const float gj = ((const LAS float*)(lds + LA_GAM))[16 * (cb0 + n) + fr];
                    f32x4 gv;
#pragma unroll
                    for (int rg = 0; rg < 4; ++rg) gv[rg] = gj * (cE[n][rg] + ((16 * (cb0 + n) + fr) == (16 * rb + 4 * fq + rg) ? 1.0f : 0.0f));
                    v2u we; we.x = pk2(gv[0], gv[1]); we.y = pk2(gv[2], gv[3]);
                    *(v2u*)(S_E + ib + (size_t)((16 * (cb0 + n) + fr) * 64 + 16 * rb + 4 * fq)) = we;
                    v2u wq; wq.x = pk2(cQ[n][0], cQ[n][1]); wq.y = pk2(cQ[n][2], cQ[n][3]);
                    *(v2u*)(S_QR + (t0 + 16 * (cb0 + n) + fr) * C + h * 64 + 16 * rb + 4 * fq) = wq;
                }
                {
                    const f32x4 g4 = *(const LAS f32x4*)(lds + LA_GAM + (16 * rb + 4 * fq) * 4);
                    v4u wh; wh.x = pk2(g4[0] * accH[0][0], g4[1] * accH[0][1]); wh.y = pk2(g4[2] * accH[0][2], g4[3] * accH[0][3]); wh.z = pk2(g4[0] * accH[1][0], g4[1] * accH[1][1]); wh.w = pk2(g4[2] * accH[1][2], g4[3] * accH[1][3]);
                    *(v4u*)((bf16*)S_HP + ib + (size_t)(((rb * 2 + (wave & 1)) * 64 + ln) * 8)) = wh;
                }
            }
        }
#undef PROD2
        if (BOTH(3)) GRID_BAR();
    }
    if (IN(4)) {
        constexpr int MS = 144;
        const int rb = wave >> 1, cb0 = 2 * (wave & 1), fr = lane & 15, fq = lane >> 4, wodd = wave & 1;
        bf16* GCg = (bf16*)(ws + WS_GC); bf16* HCg = (bf16*)(ws + WS_HC);
        struct Ops { bf16x8 e0, e1; v4u hh, h2; };
#define PB_LOAD(q, Gb, Hb, ix) do { const size_t ib_ = (size_t)(ix) * 4096; \
            q.e0 = *(const bf16x8*)((Gb) + ib_ + (16 * rb + fr) * 64 + 8 * fq); q.e1 = *(const bf16x8*)((Gb) + ib_ + (16 * rb + fr) * 64 + 8 * fq + 32); \
            q.hh = *(const v4u*)((Hb) + ib_ + ((rb * 2 + wodd) * 64 + lane) * 8); } while (0)
#define PB_STEP(q, ix, par) do { LAS unsigned char* PT = lds + ((par) & 1) * 9216; \
            _Pragma("unroll") for (int n = 0; n < 2; ++n) { v2u w; w.x = pk2(Pst[n][0], Pst[n][1]); w.y = pk2(Pst[n][2], Pst[n][3]); \
                *(LAS v2u*)(PT + (16 * (cb0 + n) + fr) * MS + (16 * rb + 4 * fq) * 2) = w; } \
            asm volatile("s_waitcnt lgkmcnt(0)" ::: "memory"); __builtin_amdgcn_s_barrier(); asm volatile("" ::: "memory"); \
            *(v4u*)(PST + (size_t)(ix) * 4096 + (tid >> 3) * 64 + (tid & 7) * 8) = *(const LAS v4u*)(PT + (tid >> 3) * MS + (tid & 7) * 16); \
            f32x4 acc0 = (f32x4){bflo(q.hh.x), bfhi(q.hh.x), bflo(q.hh.y), bfhi(q.hh.y)}, acc1 = (f32x4){bflo(q.hh.z), bfhi(q.hh.z), bflo(q.hh.w), bfhi(q.hh.w)}; \
            { const bf16x8 b00 = *(const LAS bf16x8*)(PT + (16 * cb0 + fr) * MS + 16 * fq), b10 = *(const LAS bf16x8*)(PT + (16 * (cb0 + 1) + fr) * MS + 16 * fq); \
              const bf16x8 b01 = *(const LAS bf16x8*)(PT + (16 * cb0 + fr) * MS + 16 * fq + 64), b11 = *(const LAS bf16x8*)(PT + (16 * (cb0 + 1) + fr) * MS + 16 * fq + 64); \
              acc0 = __builtin_amdgcn_mfma_f32_16x16x32_bf16(q.e0, b00, acc0, 0, 0, 0); acc1 = __builtin_amdgcn_mfma_f32_16x16x32_bf16(q.e0, b10, acc1, 0, 0, 0); \
              acc0 = __builtin_amdgcn_mfma_f32_16x16x32_bf16(q.e1, b01, acc0, 0, 0, 0); acc1 = __builtin_amdgcn_mfma_f32_16x16x32_bf16(q.e1, b11, acc1, 0, 0, 0); } \
            Pst[0] = acc0; Pst[1] = acc1; } while (0)
        for (int tk = bx; tk < 512; tk += G) {
            const int chain = tk >> 4, g = tk & 15, b = chain >> 4, h = chain & 15;
            if (g == 15) continue;
            f32x4 Sst[4];
#pragma unroll
            for (int n = 0; n < 4; ++n)
#pragma unroll
                for (int rg = 0; rg < 4; ++rg) Sst[n][rg] = (!wodd && (16 * rb + 4 * fq + rg) == (16 * n + fr)) ? 1.0f : 0.0f;
            Ops qa[8], qb[8];
#define IT(cc) ((size_t)(b * 256 + 16 * g + (cc)) * 16 + h)
#define B1_LOAD(q, cc) do { PB_LOAD(q, S_E, (const bf16*)S_HP, IT(cc)); q.hh = *(const v4u*)((const bf16*)S_HP + IT(cc) * 4096 + ((rb * 2 + 0) * 64 + lane) * 8); q.h2 = *(const v4u*)((const bf16*)S_HP + IT(cc) * 4096 + ((rb * 2 + 1) * 64 + lane) * 8); } while (0)
#define B1_STEP(q, par) do { LAS unsigned char* PT = lds + ((par) & 1) * 18432; \
                _Pragma("unroll") for (int n = 0; n < 4; ++n) { v2u w; w.x = pk2(Sst[n][0], Sst[n][1]); w.y = pk2(Sst[n][2], Sst[n][3]); \
                    *(LAS v2u*)(PT + (16 * (4 * wodd + n) + fr) * MS + (16 * rb + 4 * fq) * 2) = w; } \
                asm volatile("s_waitcnt lgkmcnt(0)" ::: "memory"); __builtin_amdgcn_s_barrier(); asm volatile("" ::: "memory"); \
                f32x4 ac[4]; const unsigned hw[8] = {q.hh.x, q.hh.y, q.hh.z, q.hh.w, q.h2.x, q.h2.y, q.h2.z, q.h2.w}; \
                _Pragma("unroll") for (int n = 0; n < 4; ++n) ac[n] = wodd ? (f32x4){bflo(hw[2 * n]), bfhi(hw[2 * n]), bflo(hw[2 * n + 1]), bfhi(hw[2 * n + 1])} : (f32x4){0.f, 0.f, 0.f, 0.f}; \
                _Pragma("unroll") for (int n = 0; n < 4; ++n) { const LAS unsigned char* br = PT + (16 * (4 * wodd + n) + fr) * MS + 16 * fq; \
                    ac[n] = __builtin_amdgcn_mfma_f32_16x16x32_bf16(q.e0, *(const LAS bf16x8*)br, ac[n], 0, 0, 0); ac[n] = __builtin_amdgcn_mfma_f32_16x16x32_bf16(q.e1, *(const LAS bf16x8*)(br + 64), ac[n], 0, 0, 0); } \
                _Pragma("unroll") for (int n = 0; n < 4; ++n) Sst[n] = ac[n]; } while (0)
            __syncthreads();
#pragma unroll
            for (int j = 0; j < 8; ++j) B1_LOAD(qa[j], j);
#pragma unroll
            for (int j = 0; j < 4; ++j) B1_STEP(qa[j], j);
#pragma unroll
            for (int j = 0; j < 4; ++j) B1_LOAD(qb[j], 8 + j);
#pragma unroll
            for (int j = 4; j < 8; ++j) B1_STEP(qa[j], j);
#pragma unroll
            for (int j = 4; j < 8; ++j) B1_LOAD(qb[j], 8 + j);
#pragma unroll
            for (int j = 0; j < 8; ++j) B1_STEP(qb[j], j);
#undef B1_LOAD
#undef B1_STEP
            if (!wodd) {
#pragma unroll
                for (int n = 0; n < 4; ++n)
#pragma unroll
                    for (int rg = 0; rg < 4; ++rg) GCg[(size_t)tk * 4096 + (16 * rb + 4 * fq + rg) * 64 + 16 * n + fr] = (bf16)f2bf(Sst[n][rg]);
            } else {
#pragma unroll
                for (int p = 0; p < 2; ++p) { v4u w; w.x = pk2(Sst[2 * p][0], Sst[2 * p][1]); w.y = pk2(Sst[2 * p][2], Sst[2 * p][3]); w.z = pk2(Sst[2 * p + 1][0], Sst[2 * p + 1][1]); w.w = pk2(Sst[2 * p + 1][2], Sst[2 * p + 1][3]);
                    *(v4u*)(HCg + (size_t)tk * 4096 + ((rb * 2 + p) * 64 + lane) * 8) = w; }
            }
        }
        GRID_BAR();
        if (bx < 32) {
            const int b = bx >> 4, h = bx & 15;
            f32x4 Pst[2]; Pst[0] = (f32x4){0.f, 0.f, 0.f, 0.f}; Pst[1] = Pst[0];
            Ops qa[8], qb[8];
            __syncthreads();
#pragma unroll
            for (int j = 0; j < 8; ++j) PB_LOAD(qa[j], GCg, HCg, bx * 16 + j);
#pragma unroll
            for (int j = 0; j < 4; ++j) PB_STEP(qa[j], (size_t)(b * 256 + 16 * j) * 16 + h, j);
#pragma unroll
            for (int j = 0; j < 4; ++j) PB_LOAD(qb[j], GCg, HCg, bx * 16 + 8 + j);
#pragma unroll
            for (int j = 4; j < 8; ++j) PB_STEP(qa[j], (size_t)(b * 256 + 16 * j) * 16 + h, j);
#pragma unroll
            for (int j = 4; j < 8; ++j) PB_LOAD(qb[j], GCg, HCg, bx * 16 + (8 + j < 15 ? 8 + j : 14));
#pragma unroll
            for (int j = 0; j < 8; ++j) PB_STEP(qb[j], (size_t)(b * 256 + 16 * (8 + j)) * 16 + h, j);
        }
        {
        {
            constexpr int KS = 144, VS = 528;
            LAS unsigned char* Ks = lds; LAS unsigned char* VT = lds + 36864;
            const int fr = lane & 15, fq = lane >> 4, hg = wave >> 1, qh = wave & 1;
            LAS int* qslot = (LAS int*)(lds + TAB_OFF + 3072);
            int nxq = 0; if (tid == 0) nxq = (int)__hip_atomic_fetch_add(ctl + CW_ATTQ, 1u, RLX_AGENT);
            for (;;) {
                __syncthreads();
                if (tid == 0) *qslot = nxq;
                __syncthreads();
                const int un = *qslot; if (un >= 2 * 128 * 4) break;
                if (tid == 0) nxq = (int)__hip_atomic_fetch_add(ctl + CW_ATTQ, 1u, RLX_AGENT);
                const int g = un & 3, nb = (un >> 2) & 127, b = un >> 9;
                const size_t tq0 = (size_t)b * SEQ + (size_t)nb * 128;
                const int head = g * 4 + hg;
                bf16x8 qf[4][2];
#pragma unroll
                for (int qt = 0; qt < 4; ++qt) { const bf16* qp = Z + (tq0 + 64 * qh + 16 * qt + fr) * IN_COLS + ZC_Q + head * 64 + 8 * fq; qf[qt][0] = *(const bf16x8*)qp; qf[qt][1] = *(const bf16x8*)(qp + 32); }
                {
                    const int key = tid >> 1, hf = tid & 1; const bool ok = (nb > 0) || key >= 128;
                    const bf16* kp = Z + (ok ? tq0 + key - 128 : tq0) * IN_COLS + ZC_KA + g * 64 + hf * 32;
                    const int key2 = tid & 255, dh = tid >> 8; const bool ok2 = (nb > 0) || key2 >= 128;
                    const bf16* vp = Z + (ok2 ? tq0 + key2 - 128 : tq0) * IN_COLS + ZC_VA + g * 64 + dh * 32;
                    v4u kv[4], vv[4];
#pragma unroll
                    for (int c = 0; c < 4; ++c) kv[c] = *(const v4u*)(kp + c * 8);
#pragma unroll
                    for (int c = 0; c < 4; ++c) vv[c] = *(const v4u*)(vp + c * 8);
#pragma unroll
                    for (int c = 0; c < 4; ++c) *(LAS v4u*)(Ks + key * KS + hf * 64 + c * 16) = kv[c];
#pragma unroll
                    for (int c = 0; c < 4; ++c) {
                        LAS unsigned char* wp = VT + (32 * (c & 1) + 8 * dh + 4 * (c >> 1)) * VS + key2 * 2;
                        *(LAS bf16*)(wp + 0 * VS) = (bf16)(vv[c].x & 0xffffu); *(LAS bf16*)(wp + 1 * VS) = (bf16)(vv[c].x >> 16); *(LAS bf16*)(wp + 2 * VS) = (bf16)(vv[c].y & 0xffffu); *(LAS bf16*)(wp + 3 * VS) = (bf16)(vv[c].y >> 16);
                        *(LAS bf16*)(wp + 16 * VS) = (bf16)(vv[c].z & 0xffffu); *(LAS bf16*)(wp + 17 * VS) = (bf16)(vv[c].z >> 16); *(LAS bf16*)(wp + 18 * VS) = (bf16)(vv[c].w & 0xffffu); *(LAS bf16*)(wp + 19 * VS) = (bf16)(vv[c].w >> 16); }
                }
                __syncthreads();
                const float sink = args.in[I_SINK][head];
#pragma unroll
                for (int qt = 0; qt < 4; ++qt) {
                    const int ql0 = 64 * qh + 16 * qt, kt0 = 4 * qh + qt, ql = ql0 + fr;
                    const bf16x8 q0 = qf[qt][0], q1 = qf[qt][1];
                    f32x4 st[9];
#pragma unroll
                    for (int j = 0; j < 9; ++j) { const LAS unsigned char* ka = Ks + (16 * (kt0 + j) + fr) * KS + 16 * fq;
                        st[j] = __builtin_amdgcn_mfma_f32_16x16x32_bf16(*(const LAS bf16x8*)ka, q0, (f32x4){0.f, 0.f, 0.f, 0.f}, 0, 0, 0);
                        st[j] = __builtin_amdgcn_mfma_f32_16x16x32_bf16(*(const LAS bf16x8*)(ka + 64), q1, st[j], 0, 0, 0); }
#pragma unroll
                    for (int rg = 0; rg < 4; ++rg) { if (!(4 * fq + rg > fr)) st[0][rg] = -3.0e38f; if (!(4 * fq + rg <= fr)) st[8][rg] = -3.0e38f; }
                    if (nb == 0) {
#pragma unroll
                        for (int j = 0; j < 9; ++j)
#pragma unroll
                            for (int rg = 0; rg < 4; ++rg) { if (16 * (kt0 + j) + 4 * fq + rg < 128) st[j][rg] = -3.0e38f; }
                    }
                    float mx = -3.0e38f;
#pragma unroll
                    for (int j = 0; j < 9; ++j)
#pragma unroll
                        for (int rg = 0; rg < 4; ++rg) mx = fmaxf(mx, st[j][rg]);
                    mx = fmaxf(mx, __shfl_xor(mx, 16)); mx = fmaxf(mx, __shfl_xor(mx, 32)); mx = fmaxf(mx * 0.125f, sink);
                    const float cs = 0.125f * 1.44269504f, mc = mx * 1.44269504f;
                    float ls = 0.f;
#pragma unroll
                    for (int j = 0; j < 9; ++j)
#pragma unroll
                        for (int rg = 0; rg < 4; ++rg) { const float p = __builtin_amdgcn_exp2f(fmaf(st[j][rg], cs, -mc)); st[j][rg] = p; ls += p; }
                    ls += __shfl_xor(ls, 16); ls += __shfl_xor(ls, 32);
                    const float inv = 1.0f / (ls + __expf(sink - mx));
                    f32x4 ot[4];
#pragma unroll
                    for (int dt = 0; dt < 4; ++dt) ot[dt] = (f32x4){0.f, 0.f, 0.f, 0.f};
#pragma unroll
                    for (int i = 0; i < 5; ++i) {
                        v4u pw; pw.x = pk2(st[2 * i][0], st[2 * i][1]); pw.y = pk2(st[2 * i][2], st[2 * i][3]);
                        if (i < 4) { pw.z = pk2(st[2 * i + 1 < 9 ? 2 * i + 1 : 8][0], st[2 * i + 1 < 9 ? 2 * i + 1 : 8][1]); pw.w = pk2(st[2 * i + 1 < 9 ? 2 * i + 1 : 8][2], st[2 * i + 1 < 9 ? 2 * i + 1 : 8][3]); } else { pw.z = 0u; pw.w = 0u; }
                        const bf16x8 pb = __builtin_bit_cast(bf16x8, pw);
#pragma unroll
                        for (int dt = 0; dt < 4; ++dt) { const LAS unsigned char* vb = VT + (16 * dt + fr) * VS + (16 * (kt0 + 2 * i) + 4 * fq) * 2;
                            const v2u lo = *(const LAS v2u*)vb; v2u hi = (v2u){0u, 0u}; if (i < 4) hi = *(const LAS v2u*)(vb + 32);
                            const bf16x8 va = __builtin_bit_cast(bf16x8, (v4u){lo.x, lo.y, hi.x, hi.y});
                            ot[dt] = __builtin_amdgcn_mfma_f32_16x16x32_bf16(va, pb, ot[dt], 0, 0, 0); }
                    }
                    { v4u w; w.x = pk4_fp8(ot[0][0] * inv, ot[0][1] * inv, ot[0][2] * inv, ot[0][3] * inv); w.y = pk4_fp8(ot[1][0] * inv, ot[1][1] * inv, ot[1][2] * inv, ot[1][3] * inv);
                      w.z = pk4_fp8(ot[2][0] * inv, ot[2][1] * inv, ot[2][2] * inv, ot[2][3] * inv); w.w = pk4_fp8(ot[3][0] * inv, ot[3][1] * inv, ot[3][2] * inv, ot[3][3] * inv);
                      *(v4u*)((unsigned char*)YA + (tq0 + ql0 + fr) * C + head * 64 + 16 * fq) = w; }
                }
            }
        }
                }
        GRID_BAR();
        for (int tk = bx; tk < 512; tk += G) {
            const int chain = tk >> 4, g = tk & 15, b = chain >> 4, h = chain & 15;
            f32x4 Pst[2];
#pragma unroll
            for (int n = 0; n < 2; ++n) { const v2u w = *(const v2u*)(PST + IT(0) * 4096 + (16 * (cb0 + n) + fr) * 64 + 16 * rb + 4 * fq); Pst[n] = (f32x4){bflo(w.x), bfhi(w.x), bflo(w.y), bfhi(w.y)}; }
            Ops qa[8], qb[8];
            __syncthreads();
#pragma unroll
            for (int j = 0; j < 8; ++j) PB_LOAD(qa[j], S_E, (const bf16*)S_HP, IT(j));
#pragma unroll
            for (int j = 0; j < 4; ++j) PB_STEP(qa[j], IT(j), j);
#pragma unroll
            for (int j = 0; j < 4; ++j) PB_LOAD(qb[j], S_E, (const bf16*)S_HP, IT(8 + j));
#pragma unroll
            for (int j = 4; j < 8; ++j) PB_STEP(qa[j], IT(j), j);
#pragma unroll
            for (int j = 4; j < 8; ++j) PB_LOAD(qb[j], S_E, (const bf16*)S_HP, IT(8 + j));
#pragma unroll
            for (int j = 0; j < 8; ++j) PB_STEP(qb[j], IT(8 + j), j);
        }
#undef IT
#undef PB_LOAD
#undef PB_STEP
        if (BOTH(4)) GRID_BAR();
    }
    if (IN(5)) {
        const int fr = lane & 15, fq = lane >> 4;
        LAS float* ybuf = (LAS float*)(lds + wave * 4608);
        const int tl = lane >> 2, c16 = (lane & 3) * 16;
        int hcur = -1; f32x4 lg[4], lb[4];
        for (int task = gw; task < 8192 * 4; task += NGW) {
            const int item = task >> 2, rb = task & 3, h = item & 15, tb = item >> 4; const size_t t0 = (size_t)tb * 64, ib = (size_t)item * 4096;
            if (h != hcur) { hcur = h;
#pragma unroll
                for (int j = 0; j < 4; ++j) { lg[j] = *(const f32x4*)(args.in[I_LNG] + h * 64 + c16 + 4 * j); lb[j] = *(const f32x4*)(args.in[I_LNB] + h * 64 + c16 + 4 * j); } }
            bf16x8 aq[2]; aq[0] = *(const bf16x8*)(S_QR + (t0 + 16 * rb + fr) * C + h * 64 + 8 * fq); aq[1] = *(const bf16x8*)(S_QR + (t0 + 16 * rb + fr) * C + h * 64 + 8 * fq + 32);
            const size_t tt = t0 + 16 * rb + tl;
            const v4u vw0 = *(const v4u*)(S_V + tt * C + h * 64 + c16), vw1 = *(const v4u*)(S_V + tt * C + h * 64 + c16 + 8);
            const v4u gw0 = *(const v4u*)(S_G + tt * C + h * 64 + c16), gw1 = *(const v4u*)(S_G + tt * C + h * 64 + c16 + 8);
            const float bdv = BDg[tt * 16 + h];
            f32x4 acc[4];
#pragma unroll
            for (int cb = 0; cb < 4; ++cb) { const v2u wy = *(const v2u*)((const bf16*)S_YL + ib + ((rb * 4 + cb) * 64 + lane) * 4); acc[cb] = (f32x4){bflo(wy.x), bfhi(wy.x), bflo(wy.y), bfhi(wy.y)}; }
#pragma unroll
            for (int cb = 0; cb < 4; ++cb)
#pragma unroll
                for (int ks = 0; ks < 2; ++ks) { const bf16x8 bp = *(const bf16x8*)(PST + ib + (16 * cb + fr) * 64 + 8 * fq + 32 * ks);
                    acc[cb] = __builtin_amdgcn_mfma_f32_16x16x32_bf16(aq[ks], bp, acc[cb], 0, 0, 0); }
#pragma unroll
            for (int cb = 0; cb < 4; ++cb)
#pragma unroll
                for (int rg = 0; rg < 4; ++rg) ybuf[(4 * fq + rg) * 68 + 16 * cb + fr] = acc[cb][rg];
            LDS_WAIT(); asm volatile("" ::: "memory");
            f32x4 y[4];
#pragma unroll
            for (int j = 0; j < 4; ++j) y[j] = *(const LAS f32x4*)(ybuf + tl * 68 + c16 + 4 * j);
            LDS_WAIT(); asm volatile("" ::: "memory");
            float s = 0.f;
#pragma unroll
            for (int j = 0; j < 4; ++j) s += (y[j][0] + y[j][1]) + (y[j][2] + y[j][3]);
            s += dpp_xor1(s); s += dpp_xor2(s);
            const float mean = s * (1.f / 64.f); float q = 0.f;
#pragma unroll
            for (int j = 0; j < 4; ++j) { y[j] = y[j] - mean; q += (y[j][0] * y[j][0] + y[j][1] * y[j][1]) + (y[j][2] * y[j][2] + y[j][3] * y[j][3]); }
            q += dpp_xor1(q); q += dpp_xor2(q);
            const float rstd = 1.0f / sqrtf(q * (1.f / 64.f) + LNX_EPS);
            const unsigned vu[8] = {vw0.x, vw0.y, vw0.z, vw0.w, vw1.x, vw1.y, vw1.z, vw1.w}, gu[8] = {gw0.x, gw0.y, gw0.z, gw0.w, gw1.x, gw1.y, gw1.z, gw1.w};
            float of[16];
#pragma unroll
            for (int j = 0; j < 8; ++j) { const int a = j >> 1, e0 = (j & 1) * 2;
                of[2 * j] = (y[a][e0] * rstd * lg[a][e0] + lb[a][e0] + bdv * bflo(vu[j])) * bflo(gu[j]);
                of[2 * j + 1] = (y[a][e0 + 1] * rstd * lg[a][e0 + 1] + lb[a][e0 + 1] + bdv * bfhi(vu[j])) * bfhi(gu[j]); }
            *(v4u*)((unsigned char*)YR + tt * C + h * 64 + c16) = (v4u){pk4_fp8(of[0], of[1], of[2], of[3]), pk4_fp8(of[4], of[5], of[6], of[7]), pk4_fp8(of[8], of[9], of[10], of[11]), pk4_fp8(of[12], of[13], of[14], of[15])};
        }
        if (BOTH(5)) GRID_BAR();
    }
#undef FRAG

    if (IN(6)) {
        ProbUp<0> P; P.K = 1024; P.S.init(NT, D, G, bx); P.A = YR; P.Bt = WuprT; P.Z = Z; P.T1in = nullptr; P.O = T1;
        pg8::gemm_phase(lds, P);
        if (BOTH(6)) { VM_WAIT(); __syncthreads(); }
    }
    if (IN(7)) {
        ProbUp<1> P; P.K = 1024; P.S.init(NT, D, G, bx); P.A = YA; P.Bt = WupaT; P.Z = Z; P.T1in = T1; P.O = MG;
        pg8::gemm_phase(lds, P);
        if (BOTH(7)) GRID_BAR();
    }
    if (IN(8)) {
        ProbOut P; P.K = 2048; P.S.init(NT, D, G, bx); P.A = MG; P.Bt = WoutT; P.X = x; P.O = X1;
        pg8::gemm_phase(lds, P);
        if (BOTH(8)) GRID_BAR();
    }
    if (IN(9)) {
        constexpr int RS = 528, WBUF = 96 * RS;
        LAS unsigned* lcnt = (LAS unsigned*)(lds + 2 * WBUF + 1024);
        if (tid < 32) lcnt[tid] = 0u;
        const int fr = lane & 15, fq = lane >> 4;
        const float br0 = args.in[I_BR][fr], br1 = args.in[I_BR][16 + fr];
        for (int base = vcu * 8; base < NT / 16; base += NGW) {
            const int task = base + wave;
            const size_t tok0 = (size_t)task * 16;
            const bf16* xp = X1 + (tok0 + fr) * D + 8 * fq;
            v2u* hp8 = (v2u*)(H8 + (tok0 + fr) * D + 8 * fq);
            f32x4 acc0 = (f32x4){0.f, 0.f, 0.f, 0.f}, acc1 = acc0; float ssq = 0.f;
            v4u wst[6], xc[8];
            __syncthreads();
#pragma unroll
            for (int i = 0; i < 6; ++i) { const int p = tid + 512 * i; wst[i] = *(const v4u*)(WrS + (size_t)(p >> 5) * 2048 + (p & 31) * 8); }
#pragma unroll
            for (int j = 0; j < 8; ++j) xc[j] = *(const v4u*)(xp + 32 * j);
#pragma unroll
            for (int i = 0; i < 6; ++i) { const int p = tid + 512 * i; *(LAS v4u*)(lds + (p >> 5) * RS + (p & 31) * 16) = wst[i]; }
            asm volatile("s_waitcnt lgkmcnt(0)" ::: "memory"); __builtin_amdgcn_s_barrier(); asm volatile("" ::: "memory");
#pragma unroll
            for (int c = 0; c < 8; ++c) {
                const LAS unsigned char* WB = lds + (c & 1) * WBUF;
                v4u xn[8];
                if (c + 1 < 8) {
#pragma unroll
                    for (int i = 0; i < 6; ++i) { const int p = tid + 512 * i; wst[i] = *(const v4u*)(WrS + (size_t)(p >> 5) * 2048 + 256 * (c + 1) + (p & 31) * 8); }
#pragma unroll
                    for (int j = 0; j < 8; ++j) xn[j] = *(const v4u*)(xp + 32 * (8 * (c + 1) + j));
                }
                asm volatile("" ::: "memory");
                bf16x8 wf[2][6];
#pragma unroll
                for (int pp = 0; pp < 6; ++pp) wf[0][pp] = *(const LAS bf16x8*)(WB + fr * RS + (8 * fq) * 2 + ((pp >> 1) * 32 + (pp & 1) * 16) * RS);
#pragma unroll
                for (int j = 0; j < 8; ++j) {
                    const v4u xw = xc[j]; const bf16x8 xa8 = __builtin_bit_cast(bf16x8, xw);
                    if (j + 1 < 8) {
#pragma unroll
                        for (int pp = 0; pp < 6; ++pp) wf[(j + 1) & 1][pp] = *(const LAS bf16x8*)(WB + fr * RS + (32 * (j + 1) + 8 * fq) * 2 + ((pp >> 1) * 32 + (pp & 1) * 16) * RS);
                    }
                    asm volatile("" ::: "memory");
#pragma unroll
                    for (int part = 2; part >= 0; --part) {
                        acc0 = __builtin_amdgcn_mfma_f32_16x16x32_bf16(xa8, wf[j & 1][2 * part], acc0, 0, 0, 0);
                        acc1 = __builtin_amdgcn_mfma_f32_16x16x32_bf16(xa8, wf[j & 1][2 * part + 1], acc1, 0, 0, 0); }
                    const float xa[8] = {bflo(xw.x), bfhi(xw.x), bflo(xw.y), bfhi(xw.y), bflo(xw.z), bfhi(xw.z), bflo(xw.w), bfhi(xw.w)};
#pragma unroll
                    for (int s8 = 0; s8 < 8; ++s8) ssq += xa[s8] * xa[s8];
                    v2u hw; hw.x = pk4_fp8(xa[0], xa[1], xa[2], xa[3]); hw.y = pk4_fp8(xa[4], xa[5], xa[6], xa[7]); hp8[4 * (8 * c + j)] = hw;
                }
                if (c + 1 < 8) {
#pragma unroll
                    for (int i = 0; i < 6; ++i) { const int p = tid + 512 * i; *(LAS v4u*)(lds + ((c + 1) & 1) * WBUF + (p >> 5) * RS + (p & 31) * 16) = wst[i]; }
#pragma unroll
                    for (int j = 0; j < 8; ++j) xc[j] = xn[j];
                    asm volatile("s_waitcnt lgkmcnt(0)" ::: "memory"); __builtin_amdgcn_s_barrier(); asm volatile("" ::: "memory");
                }
            }
            ssq += __shfl_xor(ssq, 16); ssq += __shfl_xor(ssq, 32);
            const float rstd = 1.0f / sqrtf(ssq * (1.f / D) + NORM_EPS);
            if (fq == 0) rstd_tok[tok0 + fr] = rstd;
#pragma unroll
            for (int rg = 0; rg < 4; ++rg) {
                const float rs = __shfl(rstd, 4 * fq + rg);
                float v0 = acc0[rg] * rs + br0, v1 = acc1[rg] * rs + br1;
                int ti[4]; float tv[4];
#pragma unroll
                for (int r = 0; r < 4; ++r) {
                    float m = fmaxf(v0, v1); m = fmaxf(m, dpp_xor1(m)); m = fmaxf(m, dpp_xor2(m)); m = fmaxf(m, dpp_hmir(m)); m = fmaxf(m, dpp_rmir(m));
                    const int cand = (v0 == m) ? fr : ((v1 == m) ? 16 + fr : 99);
                    float cf = (float)cand; cf = fminf(cf, dpp_xor1(cf)); cf = fminf(cf, dpp_xor2(cf)); cf = fminf(cf, dpp_hmir(cf)); cf = fminf(cf, dpp_rmir(cf));
                    const int idx = (int)cf; ti[r] = idx; tv[r] = m;
                    if (idx == fr) v0 = -3.0e38f;
                    if (idx == 16 + fr) v1 = -3.0e38f;
                }
                const float e1 = __expf(tv[1] - tv[0]), e2 = __expf(tv[2] - tv[0]), e3 = __expf(tv[3] - tv[0]);
                const float inv = 1.0f / (1.0f + e1 + e2 + e3);
                const size_t tok = tok0 + 4 * fq + rg;
                if (fr == 0) { *(int4*)(topi + tok * 4) = make_int4(ti[0], ti[1], ti[2], ti[3]); *(f32x4*)(topg + tok * 4) = (f32x4){inv, e1 * inv, e2 * inv, e3 * inv}; }
                if (fr < 4) { const int ee = fr == 0 ? ti[0] : (fr == 1 ? ti[1] : (fr == 2 ? ti[2] : ti[3])); atomicAdd((unsigned*)&lcnt[ee & 31], 1u); }
            }
        }
        __syncthreads();
        if (tid < 32 && lcnt[tid] > 0u) __hip_atomic_fetch_add(cntw + tid, lcnt[tid], RLX_AGENT);
        if (BOTH(9)) GRID_BAR();
    }
    if (IN(10)) {
        LAS unsigned* lcnt = (LAS unsigned*)(lds);
        LAS unsigned* lbase = (LAS unsigned*)(lds + 256);
        LAS unsigned* lpos = (LAS unsigned*)(lds + 512);
        if (tid < 32) { lcnt[tid] = 0u; lpos[tid] = 0u; }
        __syncthreads();
        const int tpb = NT / G;
        const int tbeg = bx * tpb;
        for (int i = tid; i < tpb * 4; i += 512) { const int ee = topi[(size_t)tbeg * 4 + i]; atomicAdd((unsigned*)&lcnt[ee], 1u); }
        __syncthreads();
        if (tid < 32) {
            unsigned tbase = 0u;
            for (int j = 0; j < tid; ++j) tbase += (__hip_atomic_load(cntw + j, RLX_AGENT) + 255u) / 256u;
            const unsigned r0 = lcnt[tid] ? __hip_atomic_fetch_add(ctl + CW_CUR + tid, lcnt[tid], RLX_AGENT) : 0u;
            lbase[tid] = tbase * 256u + r0;
        }
        __syncthreads();
        for (int i = tid; i < tpb * 4; i += 512) { const int ee = topi[(size_t)tbeg * 4 + i];
            const unsigned p = atomicAdd((unsigned*)&lpos[ee], 1u); const unsigned slot = lbase[ee] + p;
            tokslot[slot] = tbeg + (i >> 2); slotof[(size_t)tbeg * 4 + i] = (int)slot; rss[slot] = rstd_tok[tbeg + (i >> 2)]; }
        if (BOTH(10)) GRID_BAR();
    }
    if (IN(11) || IN(12)) {
        __syncthreads();
        if (tid == 0) { int t = 0;
            for (int e = 0; e < NE; ++e) { const int n = (int)((__hip_atomic_load(cntw + e, RLX_AGENT) + 255u) / 256u); for (int j = 0; j < n && t < MAX_TILES; ++j) TAB[t++] = e; }
            TAB[MAX_TILES] = t; }
        __syncthreads();
    }
    if (IN(11)) {
        ProbMoe1 P; P.K = 2048; P.S.tile_e = TAB; P.S.ntiles = __builtin_amdgcn_readfirstlane(TAB[MAX_TILES]); P.S.G = G; P.S.c = bx;
        P.H2 = H8; P.W1t = W1T; P.b1 = args.in[I_B1]; P.tokslot = tokslot; P.ACT = ACT; P.rss = rss;
        pg8::gemm_phase(lds, P);
        if (BOTH(11)) GRID_BAR();
    }
    if (IN(12)) {
        ProbMoe2 P; P.K = 2048; P.S.tile_e = TAB; P.S.ntiles = __builtin_amdgcn_readfirstlane(TAB[MAX_TILES]); P.S.G = G; P.S.c = bx;
        P.ACT = ACT; P.W2t = W2T; P.b2 = args.in[I_B2]; P.Y = Yb;
        pg8::gemm_phase(lds, P);
        if (BOTH(12)) GRID_BAR();
    }
    if (IN(13)) {
        const float* gf = args.in[I_NFG];
        for (int tok = gw; tok < NT; tok += NGW) {
            const v2u* xr = (const v2u*)(X1 + (size_t)tok * D) + lane;
            const int4 sl = *(const int4*)(slotof + (size_t)tok * 4); const f32x4 gt = *(const f32x4*)(topg + (size_t)tok * 4);
            const unsigned* y0 = (const unsigned*)(Yb + (size_t)sl.x * D) + lane; const unsigned* y1 = (const unsigned*)(Yb + (size_t)sl.y * D) + lane;
            const unsigned* y2 = (const unsigned*)(Yb + (size_t)sl.z * D) + lane; const unsigned* y3 = (const unsigned*)(Yb + (size_t)sl.w * D) + lane;
            f32x4 v[8]; float s = 0.f;
#pragma unroll
            for (int j = 0; j < 8; ++j) { { const v2u xw = xr[64 * j]; v[j] = (f32x4){bflo(xw.x), bfhi(xw.x), bflo(xw.y), bfhi(xw.y)}; } const unsigned a = y0[64 * j], b = y1[64 * j], c = y2[64 * j], d = y3[64 * j];
                const f32x2 a0 = __builtin_amdgcn_cvt_pk_f32_fp8(a, false), a1 = __builtin_amdgcn_cvt_pk_f32_fp8(a, true), b0 = __builtin_amdgcn_cvt_pk_f32_fp8(b, false), b1 = __builtin_amdgcn_cvt_pk_f32_fp8(b, true);
                const f32x2 c0 = __builtin_amdgcn_cvt_pk_f32_fp8(c, false), c1 = __builtin_amdgcn_cvt_pk_f32_fp8(c, true), d0 = __builtin_amdgcn_cvt_pk_f32_fp8(d, false), d1 = __builtin_amdgcn_cvt_pk_f32_fp8(d, true);
                v[j].x += gt.x * a0[0] + gt.y * b0[0] + gt.z * c0[0] + gt.w * d0[0];
                v[j].y += gt.x * a0[1] + gt.y * b0[1] + gt.z * c0[1] + gt.w * d0[1];
                v[j].z += gt.x * a1[0] + gt.y * b1[0] + gt.z * c1[0] + gt.w * d1[0];
                v[j].w += gt.x * a1[1] + gt.y * b1[1] + gt.z * c1[1] + gt.w * d1[1];
                s += (v[j].x * v[j].x + v[j].y * v[j].y) + (v[j].z * v[j].z + v[j].w * v[j].w); }
            const float rstd = 1.0f / sqrtf(wave_sum(s) * (1.f / D) + NORM_EPS);
            f32x4* op = (f32x4*)(args.out + (size_t)tok * D) + lane; const f32x4* gr = (const f32x4*)gf + lane;
#pragma unroll
            for (int j = 0; j < 8; ++j) { const f32x4 gg = gr[64 * j]; op[64 * j] = (f32x4){v[j].x * rstd * gg.x, v[j].y * rstd * gg.y, v[j].z * rstd * gg.z, v[j].w * rstd * gg.w}; }
        }
    }
#undef IN
#undef BOTH
}

extern "C" void kernel_launch(void* const* d_in, const int* in_sizes, int n_in, void* d_out, int out_size, void* d_ws, size_t ws_size, hipStream_t stream) {
    static int grid = 0;
    if (grid == 0) {
        if (n_in != 27 || out_size != NT * D || ws_size < WS_END) { fprintf(stderr, "kernel_launch: unexpected shapes (n_in %d out %d ws %zu)\n", n_in, out_size, ws_size); grid = -1; return; }
        int dev = 0, cus = 0;
        if (hipGetDevice(&dev) != hipSuccess || hipDeviceGetAttribute(&cus, hipDeviceAttributeMultiprocessorCount, dev) != hipSuccess) { grid = -1; return; }
        if (hipFuncSetAttribute((const void*)fwd, hipFuncAttributeMaxDynamicSharedMemorySize, LDS_BYTES) != hipSuccess) { fprintf(stderr, "kernel_launch: hipFuncSetAttribute failed\n"); grid = -1; return; }
        int per_cu = 0;
        if (hipOccupancyMaxActiveBlocksPerMultiprocessor(&per_cu, (const void*)fwd, 512, LDS_BYTES) != hipSuccess || per_cu < 1) fprintf(stderr, "kernel_launch: occupancy query reports %d\n", per_cu);
        (void)hipGetLastError();
        grid = cus;
    }
    if (grid < 0) return;
    (void)hipMemsetAsync((char*)d_ws + WS_CTL, 0, CTL_ZERO_BYTES, stream);
    Args a{};
    for (int i = 0; i < 27; ++i) a.in[i] = (const float*)d_in[i];
    a.out = (float*)d_out; a.ws = (unsigned char*)d_ws;
#if MK_N_LAUNCHES == 1
#if defined(PROBE_LO)
    a.ph_lo = 0; a.ph_hi = PROBE_HI; a.li = 0;
    hipLaunchKernelGGL(fwd, dim3(grid), dim3(512), LDS_BYTES, stream, a);
    a.ph_lo = PROBE_LO; a.ph_hi = NPHASE; a.li = 1;
    hipLaunchKernelGGL(fwd, dim3(grid), dim3(512), LDS_BYTES, stream, a);
#else
    a.ph_lo = 0; a.ph_hi = NPHASE; a.li = 0;
    hipLaunchKernelGGL(fwd, dim3(grid), dim3(512), LDS_BYTES, stream, a);
#endif
#else
    for (int p = 0; p < NPHASE; ++p) { a.ph_lo = p; a.ph_hi = p + 1; a.li = p; hipLaunchKernelGGL(fwd, dim3(grid), dim3(512), LDS_BYTES, stream, a); }
#endif
}
```

```cpp
#include <hip/hip_runtime.h>
#include <cstdio>
#include <cstdint>

#ifndef MK_N_LAUNCHES
#define MK_N_LAUNCHES 1
#endif

#define LAS __attribute__((address_space(3)))
typedef unsigned short bf16;
typedef unsigned v4u __attribute__((ext_vector_type(4)));
typedef unsigned v2u __attribute__((ext_vector_type(2)));
typedef float f32x4 __attribute__((ext_vector_type(4)));
typedef float f32x2 __attribute__((ext_vector_type(2)));
typedef short bf16x8 __attribute__((ext_vector_type(8)));
typedef int v4i __attribute__((ext_vector_type(4)));
typedef int v8i __attribute__((ext_vector_type(8)));

constexpr int NT = 32768, SEQ = 16384, D = 2048, C = 1024, NH = 16, HD = 64;
constexpr int IN_COLS = 8960;
constexpr int ZC_R = 0, ZC_K = 1024, ZC_V = 2048, ZC_LORA = 3072, ZC_Q = 3328, ZC_KA = 4352, ZC_VA = 4608, ZC_GR = 4864, ZC_GA = 6912;
constexpr int NE = 32, TOPK = 4, DFF = 2048;
constexpr int MAX_TILES = NT * TOPK / 256 + NE;
constexpr int NSLOT = MAX_TILES * 256;
constexpr float NORM_EPS = 1e-5f, LNX_EPS = 64e-5f;

constexpr size_t MiB = 1u << 20;
constexpr size_t WS_CTL = 0, CTL_ZERO_BYTES = 2 * MiB;
constexpr size_t WS_TOPI = 2 * MiB;
constexpr size_t WS_TOPG = 3 * MiB;
constexpr size_t WS_SLOT = 4 * MiB;
constexpr size_t WS_WIN_T = 8 * MiB;
constexpr size_t WS_WUPR_T = 44 * MiB;
constexpr size_t WS_WUPA_T = 48 * MiB;
constexpr size_t WS_WOUT_T = 52 * MiB;
constexpr size_t WS_WD_T = 60 * MiB, WS_WI_T = WS_WD_T + 131072, WS_WG_T = WS_WI_T + 131072;
constexpr size_t WS_WRT = 61 * MiB;
constexpr size_t WS_W1_T = 64 * MiB;
constexpr size_t WS_W2_T = 576 * MiB;
constexpr size_t WS_H = 832 * MiB;
constexpr size_t WS_Z = 960 * MiB;
constexpr size_t WS_SCAN = 1520 * MiB;
constexpr size_t WS_ACT = WS_SCAN;
constexpr size_t WS_YR = 2416 * MiB;
constexpr size_t WS_YA = 2480 * MiB;
constexpr size_t WS_T1 = 2544 * MiB;
constexpr size_t WS_MG = 2672 * MiB;
constexpr size_t WS_Y = 2800 * MiB;
constexpr size_t WS_PST = 3344 * MiB;
constexpr size_t WS_GAM = 3408 * MiB;
constexpr size_t WS_BD = 3410 * MiB;
constexpr size_t WS_X1 = 3412 * MiB;
constexpr size_t WS_GC = 3668 * MiB, WS_HC = 3672 * MiB;
constexpr size_t WS_H1F = 3676 * MiB;
constexpr size_t WS_WING = 3740 * MiB;
constexpr size_t WS_END = 3748 * MiB;
constexpr size_t SC_R = 0, SC_KF = 64 * MiB, SC_V = 128 * MiB, SC_AN = 192 * MiB, SC_BN = 256 * MiB, SC_G = 320 * MiB;
constexpr size_t SC_LW = 384 * MiB;
constexpr size_t SC_QR = 512 * MiB;
constexpr size_t SC_YL = 576 * MiB;
constexpr size_t SC_E = 704 * MiB;
constexpr size_t SC_HP = 768 * MiB;
constexpr int CW_BAR = 1024;
constexpr int CW_CNT = 8192;
constexpr int CW_CUR = 8192 + 64;
constexpr int CW_ATTQ = 8192 + 192;
constexpr int CW_TOKSLOT = 16384;
constexpr int CW_RSS = CW_TOKSLOT + NSLOT;
static_assert((CW_RSS + NSLOT) * 4 <= (int)CTL_ZERO_BYTES, "ctl");

constexpr int RING_BYTES = 131072;
constexpr int TAB_OFF = RING_BYTES;
constexpr int MISC_OFF = RING_BYTES + 4096;
constexpr int LDS_BYTES = 147456;

#define RLX_AGENT __ATOMIC_RELAXED, __HIP_MEMORY_SCOPE_AGENT
#define LDS_WAIT() asm volatile("s_waitcnt lgkmcnt(0)" ::: "memory")
#define VM_WAIT() asm volatile("s_waitcnt vmcnt(0)" ::: "memory")
__device__ __forceinline__ unsigned f2bf(float f) { return (unsigned)__builtin_bit_cast(unsigned short, (__bf16)f); }
typedef __bf16 bf2_t __attribute__((ext_vector_type(2)));
typedef short s16x4 __attribute__((ext_vector_type(4)));
__device__ __forceinline__ unsigned pk2(float lo, float hi) { bf2_t v; v[0] = (__bf16)lo; v[1] = (__bf16)hi; return __builtin_bit_cast(unsigned, v); }
__device__ __forceinline__ unsigned pk4_fp8(float a, float b, float c, float d) { unsigned w = 0u; w = __builtin_amdgcn_cvt_pk_fp8_f32(a, b, w, false); w = __builtin_amdgcn_cvt_pk_fp8_f32(c, d, w, true); return w; }
__device__ __forceinline__ float bflo(unsigned w) { return __builtin_bit_cast(float, w << 16); }
__device__ __forceinline__ float bfhi(unsigned w) { return __builtin_bit_cast(float, w & 0xffff0000u); }
__device__ __forceinline__ float bf1(bf16 b) { return __builtin_bit_cast(float, (unsigned)b << 16); }
__device__ __forceinline__ float sigmoidf_(float x) { return __builtin_amdgcn_rcpf(1.0f + __expf(-x)); }
__device__ __forceinline__ float wave_sum(float v) {
#pragma unroll
    for (int o = 1; o < 64; o <<= 1) v += __shfl_xor(v, o);
    return v;
}

#define XB_TMO      128
#define XB_XCNT(j)  (256  + 64 * (j))
#define XB_XSUB(j)  (1280 + 64 * (j))
#define XB_XGEN(j)  (2304 + 64 * (j))
#define XB_TOP      3328
#define XB_TOPGEN   3392
#define XCD_BAR_WORDS 3456
#define XB_SPIN_CAP (1u << 22)
__device__ __forceinline__ unsigned xb_ld(unsigned* p)              { return __hip_atomic_load(p, __ATOMIC_RELAXED, __HIP_MEMORY_SCOPE_AGENT); }
__device__ __forceinline__ unsigned xb_add(unsigned* p, unsigned v) { return __hip_atomic_fetch_add(p, v, __ATOMIC_RELAXED, __HIP_MEMORY_SCOPE_AGENT); }
__device__ __forceinline__ unsigned xb_xcc_id() { return (unsigned)__builtin_amdgcn_s_getreg((3 << 11) | 20) & 0xFu; }
#define XB_SPIN(cond, bar) do { unsigned _sp = 0; while (cond) { __builtin_amdgcn_s_sleep(1); \
    if ((++_sp & 255u) == 0u) { if (xb_ld(&(bar)[XB_TMO])) break; if (_sp > XB_SPIN_CAP) { atomicAdd(&(bar)[XB_TMO], 1u); break; } } } } while (0)
struct XcdBarrier { unsigned* bar; unsigned x; volatile LAS unsigned* st; };
__device__ __forceinline__ XcdBarrier xcd_barrier_post(unsigned* bar, volatile LAS unsigned* st) {
    XcdBarrier b; b.bar = bar; b.x = xb_xcc_id(); b.st = st;
    if (threadIdx.x == 0) (void)xb_add(&bar[XB_XCNT(b.x)], 1u);
    return b;
}
__device__ __forceinline__ void xcd_barrier_complete(unsigned* bar, unsigned x, unsigned& nloc, unsigned& nx) {
    const unsigned G = gridDim.x * gridDim.y * gridDim.z;
    unsigned sum, cnt, mine, sp = 0u;
    for (;;) {
        sum = 0u; cnt = 0u; mine = 0u;
#pragma unroll
        for (unsigned j = 0; j < 16; ++j) { const unsigned c = xb_ld(&bar[XB_XCNT(j)]); sum += c; cnt += (c > 0u) ? 1u : 0u; mine = (j == x) ? c : mine; }
        if (sum == G) break;
        __builtin_amdgcn_s_sleep(1);
        if ((++sp & 255u) == 0u) { if (xb_ld(&bar[XB_TMO])) break; if (sp > XB_SPIN_CAP) { atomicAdd(&bar[XB_TMO], 1u); break; } }
    }
    nloc = mine > 0u ? mine : 1u; nx = cnt > 0u ? cnt : 1u;
}
__device__ __forceinline__ void xcd_barrier(const XcdBarrier& b) {
    asm volatile("s_waitcnt vmcnt(0)" ::: "memory");
    __syncthreads();
    if (threadIdx.x == 0) {
        unsigned* bar = b.bar;
        __builtin_amdgcn_s_waitcnt(0);
        unsigned nloc = b.st[0], nx = b.st[1];
        if (nloc == 0u) { xcd_barrier_complete(bar, b.x, nloc, nx); b.st[0] = nloc; b.st[1] = nx; }
        const unsigned old = xb_add(&bar[XB_XSUB(b.x)], 1u);
        const unsigned gen = old / nloc;
        if (old + 1u == (gen + 1u) * nloc) {
            __builtin_amdgcn_fence(__ATOMIC_RELEASE, "agent");
            asm volatile("s_waitcnt vmcnt(0)" ::: "memory");
            const unsigned og = xb_add(&bar[XB_TOP], 1u);
            const unsigned tg = og / nx;
            if (og + 1u == (tg + 1u) * nx) xb_add(&bar[XB_TOPGEN], 1u);
            else XB_SPIN(xb_ld(&bar[XB_TOPGEN]) == tg, bar);
            __builtin_amdgcn_fence(__ATOMIC_ACQUIRE, "agent");
            xb_add(&bar[XB_XGEN(b.x)], 1u);
            asm volatile("s_waitcnt vmcnt(0)" ::: "memory");
        } else {
            XB_SPIN(xb_ld(&bar[XB_XGEN(b.x)]) == gen, bar);
            __builtin_amdgcn_fence(__ATOMIC_ACQUIRE, "agent");
            asm volatile("s_waitcnt vmcnt(0)" ::: "memory");
        }
    }
    __syncthreads();
}

namespace pg8 {
constexpr int BM = 256, BK = 64, HALF = 128, HTB = HALF * BK * 2, STAGE_BYTES = 8 * HTB, NXCD = 8, WGM = 8;
__device__ __forceinline__ int lds_byte(int r, int c) { const int st = (r >> 4) * 2 + (c >> 5), rr = r & 15, cc = c & 31, ob = rr * 64 + cc * 2; return st * 1024 + (ob ^ (((ob >> 9) & 1) << 5)); }
__device__ __forceinline__ void stage_rc(int b, int& R, int& Cc) { const int st = b / 1024, sb = b % 1024, swz = sb ^ (((sb >> 9) & 1) << 5); R = (st >> 1) * 16 + swz / 64; Cc = (st & 1) * 32 + (swz % 64) / 2; }
__device__ __forceinline__ int perm32(int rho) { const int n = rho >> 4, i = rho & 15; return 8 * (i >> 2) + 4 * n + (i & 3); }
struct Unit { int pm, pn, e; };
__device__ __forceinline__ int xcd_remap(int wgid, int nwg) { const int q = nwg / NXCD, r = nwg % NXCD, xcd = wgid % NXCD, off = wgid / NXCD; return (xcd < r ? xcd * (q + 1) : r * (q + 1) + (xcd - r) * q) + off; }
struct DenseOrder {
    int nM, nN, nwg, G, c;
    __device__ __forceinline__ void init(int M, int N, int G_, int c_) { nM = M / BM; nN = N / BM; nwg = nM * nN; G = G_; c = c_; }
    __device__ __forceinline__ bool next(int i, Unit& u) const {
        const long L = (long)i * G + c; if (L >= nwg) return false;
        const int wgid = xcd_remap((int)L, nwg);
        const int nig = WGM * nN, gid = wgid / nig, fm = gid * WGM, gsz = (nM - fm) < WGM ? (nM - fm) : WGM;
        u.pm = fm + ((wgid % nig) % gsz); u.pn = (wgid % nig) / gsz; u.e = 0; return true;
    }
};
struct BalancedOrder {
    int nM, nN, nwg, G, c, rem, base, extra;
    __device__ __forceinline__ void init(int M, int N, int G_, int c_, int rem_, int extra_) { nM = M / BM; nN = N / BM; nwg = nM * nN; G = G_; c = c_; rem = rem_; extra = extra_;
        const int t = nwg - extra_ * (G_ - rem_); base = (t >= 0 && t % G_ == 0) ? t / G_ : -1; }
    __device__ __forceinline__ bool next(int i, Unit& u) const {
        long L;
        if (base < 0) { L = (long)i * G + c; if (L >= nwg) return false; }
        else if (i < base) L = (long)i * G + c;
        else if (c >= rem && i < base + extra) L = (long)base * G + (long)(i - base) * (G - rem) + (c - rem);
        else return false;
        const int wgid = xcd_remap((int)L, nwg);
        const int nig = WGM * nN, gid = wgid / nig, fm = gid * WGM, gsz = (nM - fm) < WGM ? (nM - fm) : WGM;
        u.pm = fm + ((wgid % nig) % gsz); u.pn = (wgid % nig) / gsz; u.e = 0; return true;
    }
};
template <int NPN> struct MoeOrder {
    const LAS int* tile_e; int ntiles, G, c;
    __device__ __forceinline__ bool next(int i, Unit& u) const {
        const long L = (long)i * G + c; const int nwg = ntiles * NPN; if (L >= nwg) return false;
        const int wgid = xcd_remap((int)L, nwg);
        { const int nig = WGM * NPN, gid = wgid / nig, fm = gid * WGM, gsz = (ntiles - fm) < WGM ? (ntiles - fm) : WGM;
          u.pm = fm + ((wgid % nig) % gsz); u.pn = (wgid % nig) / gsz; }
        u.e = __builtin_amdgcn_readfirstlane(tile_e[u.pm]); return true;
    }
};
typedef f32x4 Acc[2][2][4][2];

template <class Prob>
__device__ __forceinline__ void gemm_phase(LAS unsigned char* lds, const Prob& P) {
    int tid = threadIdx.x; asm volatile("" : "+v"(tid));
    const int wid = __builtin_amdgcn_readfirstlane(tid >> 6), lane = tid & 63, wr = wid >> 2, wc = wid & 3, fr = lane & 15, fq = lane >> 4;
    const int K = P.K, nt = Prob::FP8 ? K / 128 : K / BK;
    constexpr int EB = Prob::FP8 ? 1 : 2;
    unsigned voffB[2], voffA[2]; int Rst[2]; unsigned cst[2];
#pragma unroll
    for (int i = 0; i < 2; ++i) { int R, Cc; stage_rc(tid * 16 + i * 8192, R, Cc); const int p_ = perm32(R & 31); const int Rb = Prob::PERM64 ? (64 * (R >> 5) + 16 * (p_ >> 3) + (p_ & 7)) : (Prob::PERM ? ((R & ~31) + p_) : R);
        Rst[i] = R; cst[i] = (unsigned)Cc * 2u; voffA[i] = (unsigned)(R * K * EB + Cc * 2); voffB[i] = (unsigned)(Rb * K * EB + Cc * 2); }
    const size_t kstep = (size_t)(BK * 2);
    const unsigned ldsw = (unsigned)wid * 1024u;
    const int aoff = lds_byte(wr * 64 + fr, fq * 8), boff = lds_byte(wc * 32 + fr, fq * 8);
#define PG8_SA(b, h) (((b) * 2 + (h)) * HTB)
#define PG8_SB(b, h) ((4 + (b) * 2 + (h)) * HTB)
#define PG8_STAGE(bufoff, gbase, v0, v1) do { \
        __builtin_amdgcn_global_load_lds((const unsigned*)((const char*)(gbase) + (v0)), (LAS unsigned*)(lds + (bufoff) + ldsw), 16, 0, 0); \
        __builtin_amdgcn_global_load_lds((const unsigned*)((const char*)(gbase) + (v1)), (LAS unsigned*)(lds + (bufoff) + ldsw + 8192), 16, 0, 0); } while (0)
#define PG8_LD8(dst, off) do { const v4i lo_ = *(const LAS v4i*)(lds + (off)); const v4i hi_ = *(const LAS v4i*)(lds + (off) + 1024); dst = __builtin_shufflevector(lo_, hi_, 0, 1, 2, 3, 4, 5, 6, 7); } while (0)
#define PG8_LDA(dst, b, h) do { _Pragma("unroll") for (int m = 0; m < 4; ++m) PG8_LD8(dst[m], PG8_SA(b, h) + aoff + m * 2048); } while (0)
#define PG8_LDB(dst, b, h) do { _Pragma("unroll") for (int n = 0; n < 2; ++n) PG8_LD8(dst[n], PG8_SB(b, h) + boff + n * 2048); } while (0)
#define PG8_MMA(ai, bj, At, Bt) do { __builtin_amdgcn_s_setprio(1); if constexpr (Prob::FP8) asm volatile("s_nop 1"); _Pragma("unroll") for (int m = 0; m < 4; ++m) _Pragma("unroll") for (int n = 0; n < 2; ++n) { \
        if constexpr (Prob::FP8) asm volatile("v_mfma_scale_f32_16x16x128_f8f6f4 %0, %1, %2, %0, %3, %4 op_sel_hi:[0,0,0]" : "+v"(acc[ai][bj][m][n]) : "v"(Bt[n]), "v"(At[m]), "v"(sc_w), "v"(sc_a));   \
        else { acc[ai][bj][m][n] = __builtin_amdgcn_mfma_f32_16x16x32_bf16((bf16x8)__builtin_shufflevector(Bt[n], Bt[n], 0, 1, 2, 3), (bf16x8)__builtin_shufflevector(At[m], At[m], 0, 1, 2, 3), acc[ai][bj][m][n], 0, 0, 0); \
               acc[ai][bj][m][n] = __builtin_amdgcn_mfma_f32_16x16x32_bf16((bf16x8)__builtin_shufflevector(Bt[n], Bt[n], 4, 5, 6, 7), (bf16x8)__builtin_shufflevector(At[m], At[m], 4, 5, 6, 7), acc[ai][bj][m][n], 0, 0, 0); } } \
        __builtin_amdgcn_s_setprio(0); } while (0)
#define PG8_WAIT_V(n) asm volatile("s_waitcnt vmcnt(" #n ")" ::: "memory")
#define PG8_WAIT_L(n) asm volatile("s_waitcnt lgkmcnt(" #n ")" ::: "memory")
#define PG8_BAR __builtin_amdgcn_s_barrier()
#define PG8_SCHED __builtin_amdgcn_sched_barrier(0)
    Unit cur, nxt; int ui = 0;
    if (!P.next(0, cur)) return;
    Acc acc;
#pragma unroll
    for (int a = 0; a < 2; ++a)
#pragma unroll
        for (int b = 0; b < 2; ++b)
#pragma unroll
            for (int m = 0; m < 4; ++m)
#pragma unroll
                for (int n = 0; n < 2; ++n) acc[a][b][m][n] = (f32x4){0.f, 0.f, 0.f, 0.f};
    v8i At[4], B0[2], B1[2];
    int sc_w = 121, sc_a = 127;
    if constexpr (Prob::FP8) asm volatile("" : "+v"(sc_w), "+v"(sc_a));
    const char *cA0 = P.a_base(cur, 0), *cA1 = P.a_base(cur, 1), *cB0 = P.b_base(cur, 0), *cB1 = P.b_base(cur, 1);
    unsigned c00 = voffA[0], c01 = voffA[1], c10 = voffA[0], c11 = voffA[1];
    unsigned n00 = c00, n01 = c01, n10 = c10, n11 = c11;
    if constexpr (Prob::GATHER) { c00 = P.gather(cur, 0, Rst[0]) + cst[0]; c01 = P.gather(cur, 0, Rst[1]) + cst[1]; c10 = P.gather(cur, 1, Rst[0]) + cst[0]; c11 = P.gather(cur, 1, Rst[1]) + cst[1]; }
    PG8_STAGE(PG8_SB(0, 0), cB0, voffB[0], voffB[1]); PG8_STAGE(PG8_SB(0, 1), cB1, voffB[0], voffB[1]); PG8_STAGE(PG8_SA(0, 0), cA0, c00, c01); PG8_STAGE(PG8_SA(0, 1), cA1, c10, c11);
    if (wr == 1) PG8_BAR;
    PG8_WAIT_V(2); PG8_BAR;
    PG8_STAGE(PG8_SB(1, 0), cB0 + kstep, voffB[0], voffB[1]); PG8_STAGE(PG8_SB(1, 1), cB1 + kstep, voffB[0], voffB[1]);
    PG8_WAIT_V(4); PG8_BAR;
    for (;;) {
        const bool has_next = P.next(ui + 1, nxt);
        const char *nA0 = cA0, *nA1 = cA1, *nB0 = cB0, *nB1 = cB1;
        if (has_next) { nA0 = P.a_base(nxt, 0); nA1 = P.a_base(nxt, 1); nB0 = P.b_base(nxt, 0); nB1 = P.b_base(nxt, 1); }
        if constexpr (Prob::GATHER) {
            if (has_next) { n00 = P.gather(nxt, 0, Rst[0]) + cst[0]; n01 = P.gather(nxt, 0, Rst[1]) + cst[1]; n10 = P.gather(nxt, 1, Rst[0]) + cst[0]; n11 = P.gather(nxt, 1, Rst[1]) + cst[1]; }
            else { n00 = c00; n01 = c01; n10 = c10; n11 = c11; }
        }
        for (int t = 0; t < nt; t += 2) {
            const bool last = (t == nt - 2);
            const char* a1h1 = cA1 + (size_t)(t + 1) * kstep;
            const char* a2h0 = last ? nA0 : cA0 + (size_t)(t + 2) * kstep; const char* a2h1 = last ? nA1 : cA1 + (size_t)(t + 2) * kstep;
            const char* b2h0 = last ? nB0 : cB0 + (size_t)(t + 2) * kstep; const char* b2h1 = last ? nB1 : cB1 + (size_t)(t + 2) * kstep;
            const char* b3h0 = b2h0 + kstep; const char* b3h1 = b2h1 + kstep;
            unsigned v00 = c00, v01 = c01, v10 = c10, v11 = c11;
            if constexpr (Prob::GATHER) { if (last) { v00 = n00; v01 = n01; v10 = n10; v11 = n11; }
                asm volatile("" : "+v"(v00), "+v"(v01), "+v"(v10), "+v"(v11)); }
            unsigned w10 = c10, w11 = c11; if constexpr (Prob::GATHER) asm volatile("" : "+v"(w10), "+v"(w11));
            const char* a1h0 = cA0 + (size_t)(t + 1) * kstep;
            unsigned w00 = c00, w01 = c01; if constexpr (Prob::GATHER) asm volatile("" : "+v"(w00), "+v"(w01));
            PG8_LDB(B0, 0, 0); PG8_LDB(B1, 0, 1); PG8_SCHED; PG8_LDA(At, 0, 0); PG8_STAGE(PG8_SA(1, 0), a1h0, w00, w01); PG8_STAGE(PG8_SA(1, 1), a1h1, w10, w11);
            PG8_WAIT_V(8); PG8_WAIT_L(0); PG8_BAR; PG8_MMA(0, 0, At, B0); PG8_MMA(0, 1, At, B1); PG8_BAR; PG8_SCHED;
            PG8_LDA(At, 0, 1); PG8_STAGE(PG8_SB(0, 0), b2h0, voffB[0], voffB[1]); PG8_STAGE(PG8_SB(0, 1), b2h1, voffB[0], voffB[1]);
            PG8_WAIT_V(6); PG8_WAIT_L(0); PG8_BAR; PG8_MMA(1, 0, At, B0); PG8_MMA(1, 1, At, B1); PG8_BAR; PG8_SCHED;
            PG8_LDB(B0, 1, 0); PG8_LDB(B1, 1, 1); PG8_SCHED; PG8_LDA(At, 1, 0); PG8_STAGE(PG8_SA(0, 0), a2h0, v00, v01); PG8_STAGE(PG8_SA(0, 1), a2h1, v10, v11);
            PG8_WAIT_V(8); PG8_WAIT_L(0); PG8_BAR; PG8_MMA(0, 0, At, B0); PG8_MMA(0, 1, At, B1); PG8_BAR; PG8_SCHED;
            PG8_LDA(At, 1, 1); PG8_STAGE(PG8_SB(1, 0), b3h0, voffB[0], voffB[1]); PG8_STAGE(PG8_SB(1, 1), b3h1, voffB[0], voffB[1]);
            PG8_WAIT_V(6); PG8_WAIT_L(0); PG8_BAR; PG8_MMA(1, 0, At, B0); PG8_MMA(1, 1, At, B1); PG8_BAR; PG8_SCHED;
        }
        if (wr == 0) PG8_BAR;
        if constexpr (Prob::FP8) asm volatile("s_nop 15\n\ts_nop 15" ::: "memory");
        P.epi(acc, cur, wr, wc, fr, fq);
        if (!has_next) break;
#pragma unroll
        for (int a = 0; a < 2; ++a)
#pragma unroll
            for (int b = 0; b < 2; ++b)
#pragma unroll
                for (int m = 0; m < 4; ++m)
#pragma unroll
                    for (int n = 0; n < 2; ++n) acc[a][b][m][n] = (f32x4){0.f, 0.f, 0.f, 0.f};
        cur = nxt; cA0 = nA0; cA1 = nA1; cB0 = nB0; cB1 = nB1; ++ui;
        if constexpr (Prob::GATHER) { c00 = n00; c01 = n01; c10 = n10; c11 = n11; }
        if (wr == 1) PG8_BAR;
    }
    PG8_WAIT_V(0);
    PG8_BAR;
#undef PG8_SA
#undef PG8_SB
#undef PG8_STAGE
#undef PG8_LD8
#undef PG8_LDA
#undef PG8_LDB
#undef PG8_MMA
#undef PG8_WAIT_V
#undef PG8_WAIT_L
#undef PG8_BAR
#undef PG8_SCHED
}
}

using pg8::Unit; using pg8::Acc;
struct ProbIn {
    static constexpr bool PERM = true, GATHER = false, FP8 = false, PERM64 = false;
    int K; pg8::DenseOrder S; const bf16* A; const bf16* Bt; bf16* Z; const float* bqkv;
    __device__ __forceinline__ bool next(int i, Unit& u) const { return S.next(i, u); }
    __device__ __forceinline__ const char* a_base(const Unit& u, int h) const { return (const char*)A + (size_t)(u.pm * 256 + h * 128) * K * 2; }
    __device__ __forceinline__ const char* b_base(const Unit& u, int h) const { return (const char*)Bt + (size_t)(u.pn * 256 + h * 128) * K * 2; }
    __device__ __forceinline__ void epi(const Acc& acc, const Unit& u, int wr, int wc, int fr, int fq) const {
        const int row0 = u.pm * 256 + wr * 64 + fr, col0 = u.pn * 256 + wc * 32 + 8 * fq;
        const int mode = u.pn < 13 ? 0 : 1;
        f32x4 bv[2][2];
#pragma unroll
        for (int bj = 0; bj < 2; ++bj)
#pragma unroll
            for (int n = 0; n < 2; ++n) bv[bj][n] = (mode == 1) ? *(const f32x4*)(bqkv + (col0 - ZC_Q) + bj * 128 + 4 * n) : (f32x4){0.f, 0.f, 0.f, 0.f};
#pragma unroll
        for (int ai = 0; ai < 2; ++ai)
#pragma unroll
            for (int m = 0; m < 4; ++m) { bf16* rowp = Z + (size_t)(row0 + ai * 128 + m * 16) * IN_COLS + col0;
#pragma unroll
                for (int bj = 0; bj < 2; ++bj) { f32x4 v0 = acc[ai][bj][m][0] + bv[bj][0], v1 = acc[ai][bj][m][1] + bv[bj][1];
                    v4u w; w.x = pk2(v0[0], v0[1]); w.y = pk2(v0[2], v0[3]); w.z = pk2(v1[0], v1[1]); w.w = pk2(v1[2], v1[3]);
                    *(v4u*)(rowp + bj * 128) = w; } }
    }
};
struct ProbInG {
    static constexpr bool PERM = true, GATHER = false, FP8 = true, PERM64 = false;
    int K; pg8::BalancedOrder S; const unsigned char* A; const unsigned char* Bt; bf16* Z;
    __device__ __forceinline__ bool next(int i, Unit& u) const { return S.next(i, u); }
    __device__ __forceinline__ const char* a_base(const Unit& u, int h) const { return (const char*)A + (size_t)(u.pm * 256 + h * 128) * K; }
    __device__ __forceinline__ const char* b_base(const Unit& u, int h) const { return (const char*)Bt + (size_t)(u.pn * 256 + h * 128) * K; }
    __device__ __forceinline__ void epi(const Acc& acc, const Unit& u, int wr, int wc, int fr, int fq) const {
        const int row0 = u.pm * 256 + wr * 64 + fr, col0 = ZC_GR + u.pn * 256 + wc * 32 + 8 * fq;
#pragma unroll
        for (int ai = 0; ai < 2; ++ai)
#pragma unroll
            for (int m = 0; m < 4; ++m) { bf16* rowp = Z + (size_t)(row0 + ai * 128 + m * 16) * IN_COLS + col0;
#pragma unroll
                for (int bj = 0; bj < 2; ++bj) { f32x4 v0 = acc[ai][bj][m][0], v1 = acc[ai][bj][m][1];
#pragma unroll
                    for (int j = 0; j < 4; ++j) { v0[j] = sigmoidf_(v0[j]); v1[j] = sigmoidf_(v1[j]); }
                    v4u w; w.x = pk2(v0[0], v0[1]); w.y = pk2(v0[2], v0[3]); w.z = pk2(v1[0], v1[1]); w.w = pk2(v1[2], v1[3]);
                    *(v4u*)(rowp + bj * 128) = w; } }
    }
};
template <int MODE> struct ProbUp {
    static constexpr bool PERM = true, GATHER = false, FP8 = true, PERM64 = false;
    int K; pg8::DenseOrder S; const bf16* A; const bf16* Bt; const bf16* Z; const bf16* T1in; bf16* O;
    __device__ __forceinline__ bool next(int i, Unit& u) const { return S.next(i, u); }
    __device__ __forceinline__ const char* a_base(const Unit& u, int h) const { return (const char*)A + (size_t)(u.pm * 256 + h * 128) * K; }
    __device__ __forceinline__ const char* b_base(const Unit& u, int h) const { return (const char*)Bt + (size_t)(u.pn * 256 + h * 128) * K; }
    __device__ __forceinline__ void epi(const Acc& acc, const Unit& u, int wr, int wc, int fr, int fq) const {
        const int row0 = u.pm * 256 + wr * 64 + fr, col0 = u.pn * 256 + wc * 32 + 8 * fq;
#pragma unroll
        for (int ai = 0; ai < 2; ++ai)
#pragma unroll
            for (int m = 0; m < 4; ++m) { const size_t r = (size_t)(row0 + ai * 128 + m * 16);
#pragma unroll
                for (int bj = 0; bj < 2; ++bj) { const int col = col0 + bj * 128;
                    const v4u g = *(const v4u*)(Z + r * IN_COLS + (MODE == 0 ? ZC_GR : ZC_GA) + col);
                    f32x4 v0 = acc[ai][bj][m][0], v1 = acc[ai][bj][m][1];
                    v0[0] *= bflo(g.x); v0[1] *= bfhi(g.x); v0[2] *= bflo(g.y); v0[3] *= bfhi(g.y); v1[0] *= bflo(g.z); v1[1] *= bfhi(g.z); v1[2] *= bflo(g.w); v1[3] *= bfhi(g.w);
                    if (MODE == 1) { const v4u t = *(const v4u*)(T1in + r * D + col);
                        v0[0] += bflo(t.x); v0[1] += bfhi(t.x); v0[2] += bflo(t.y); v0[3] += bfhi(t.y); v1[0] += bflo(t.z); v1[1] += bfhi(t.z); v1[2] += bflo(t.w); v1[3] += bfhi(t.w); }
                    if (MODE == 1) { v2u w8; w8.x = pk4_fp8(v0[0], v0[1], v0[2], v0[3]); w8.y = pk4_fp8(v1[0], v1[1], v1[2], v1[3]); *(v2u*)((unsigned char*)O + r * D + col) = w8; }
                    else { v4u w; w.x = pk2(v0[0], v0[1]); w.y = pk2(v0[2], v0[3]); w.z = pk2(v1[0], v1[1]); w.w = pk2(v1[2], v1[3]);
                        *(v4u*)(O + r * D + col) = w; } } }
    }
};
struct ProbOut {
    static constexpr bool PERM = true, GATHER = false, FP8 = true, PERM64 = false;
    int K; pg8::DenseOrder S; const bf16* A; const bf16* Bt; const float* X; bf16* O;
    __device__ __forceinline__ bool next(int i, Unit& u) const { return S.next(i, u); }
    __device__ __forceinline__ const char* a_base(const Unit& u, int h) const { return (const char*)A + (size_t)(u.pm * 256 + h * 128) * K; }
    __device__ __forceinline__ const char* b_base(const Unit& u, int h) const { return (const char*)Bt + (size_t)(u.pn * 256 + h * 128) * K; }
    __device__ __forceinline__ void epi(const Acc& acc, const Unit& u, int wr, int wc, int fr, int fq) const {
        const int row0 = u.pm * 256 + wr * 64 + fr, col0 = u.pn * 256 + wc * 32 + 8 * fq;
#pragma unroll
        for (int ai = 0; ai < 2; ++ai)
#pragma unroll
            for (int m = 0; m < 4; ++m) { const size_t off = (size_t)(row0 + ai * 128 + m * 16) * D + col0;
#pragma unroll
                for (int bj = 0; bj < 2; ++bj) { const f32x4 x0 = *(const f32x4*)(X + off + bj * 128), x1v = *(const f32x4*)(X + off + bj * 128 + 4);
                    const f32x4 v0 = x0 + acc[ai][bj][m][0], v1 = x1v + acc[ai][bj][m][1];
                    v4u w; w.x = pk2(v0[0], v0[1]); w.y = pk2(v0[2], v0[3]); w.z = pk2(v1[0], v1[1]); w.w = pk2(v1[2], v1[3]);
                    *(v4u*)(O + off + bj * 128) = w; } }
    }
};
struct ProbMoe1 {
    static constexpr bool PERM = true, GATHER = true, FP8 = true, PERM64 = false;
    int K; pg8::MoeOrder<16> S; const unsigned char* H2; const unsigned char* W1t; const float* b1; const int* tokslot; unsigned char* ACT; const float* rss;
    __device__ __forceinline__ bool next(int i, Unit& u) const { return S.next(i, u); }
    __device__ __forceinline__ const char* a_base(const Unit& u, int h) const { return (const char*)H2; }
    __device__ __forceinline__ const char* b_base(const Unit& u, int h) const { return (const char*)W1t + ((size_t)u.e * 4096 + (size_t)h * 2048 + (size_t)u.pn * 128) * K; }
    __device__ __forceinline__ unsigned gather(const Unit& u, int h, int R) const { return (unsigned)tokslot[u.pm * 256 + h * 128 + R] * (unsigned)K; }
    __device__ __forceinline__ void epi(const Acc& acc, const Unit& u, int wr, int wc, int fr, int fq) const {
        const int row0 = u.pm * 256 + wr * 64 + fr, colg = u.pn * 128 + wc * 32 + 8 * fq;
        const float* bp = b1 + (size_t)u.e * 4096 + colg;
        const f32x4 bg0 = *(const f32x4*)(bp), bg1 = *(const f32x4*)(bp + 4), bl0 = *(const f32x4*)(bp + 2048) + 1.0f, bl1 = *(const f32x4*)(bp + 2048 + 4) + 1.0f;
        float rsv[2][4];
#pragma unroll
        for (int ai = 0; ai < 2; ++ai)
#pragma unroll
            for (int m = 0; m < 4; ++m) rsv[ai][m] = rss[row0 + ai * 128 + m * 16];
#pragma unroll
        for (int ai = 0; ai < 2; ++ai)
#pragma unroll
            for (int m = 0; m < 4; ++m) {
                float o[8];
                const f32x2 rs2 = (f32x2){rsv[ai][m], rsv[ai][m]};
#pragma unroll
                for (int n = 0; n < 2; ++n)
#pragma unroll
                    for (int jp = 0; jp < 2; ++jp) {
                        const f32x4 ag = acc[ai][0][m][n], al = acc[ai][1][m][n], bg = n ? bg1 : bg0, bl = n ? bl1 : bl0;
                        f32x2 g = (f32x2){ag[2 * jp], ag[2 * jp + 1]} * rs2 + (f32x2){bg[2 * jp], bg[2 * jp + 1]};
                        f32x2 l1 = (f32x2){al[2 * jp], al[2 * jp + 1]} * rs2 + (f32x2){bl[2 * jp], bl[2 * jp + 1]};
                        g.x = fminf(g.x, 7.0f); g.y = fminf(g.y, 7.0f); l1.x = fminf(fmaxf(l1.x, -6.0f), 8.0f); l1.y = fminf(fmaxf(l1.y, -6.0f), 8.0f);
                        const f32x2 t = g * (-1.702f * 1.44269504f);
                        f32x2 d = (f32x2){__builtin_amdgcn_exp2f(t.x), __builtin_amdgcn_exp2f(t.y)} + 1.0f;
                        const f32x2 r = (f32x2){__builtin_amdgcn_rcpf(d.x), __builtin_amdgcn_rcpf(d.y)};
                        const f32x2 ov = g * r * l1;
                        o[n * 4 + 2 * jp] = ov.x; o[n * 4 + 2 * jp + 1] = ov.y; }
                v2u w; w.x = pk4_fp8(o[0], o[1], o[2], o[3]); w.y = pk4_fp8(o[4], o[5], o[6], o[7]);
                *(v2u*)(ACT + (size_t)(row0 + ai * 128 + m * 16) * DFF + colg) = w; }
    }
};
struct ProbMoe2 {
    static constexpr bool PERM = true, GATHER = false, FP8 = true, PERM64 = true;
    int K; pg8::MoeOrder<8> S; const unsigned char* ACT; const unsigned char* W2t; const float* b2; unsigned char* Y;
    __device__ __forceinline__ bool next(int i, Unit& u) const { return S.next(i, u); }
    __device__ __forceinline__ const char* a_base(const Unit& u, int h) const { return (const char*)ACT + (size_t)(u.pm * 256 + h * 128) * K; }
    __device__ __forceinline__ const char* b_base(const Unit& u, int h) const { return (const char*)W2t + ((size_t)u.e * 2048 + (size_t)u.pn * 256 + (size_t)h * 8) * K; }
    __device__ __forceinline__ void epi(const Acc& acc, const Unit& u, int wr, int wc, int fr, int fq) const {
        const int row0 = u.pm * 256 + wr * 64 + fr, col0 = u.pn * 256 + wc * 64 + 16 * fq;
        f32x4 bv[2][2];
#pragma unroll
        for (int bj = 0; bj < 2; ++bj)
#pragma unroll
            for (int n = 0; n < 2; ++n) bv[bj][n] = *(const f32x4*)(b2 + (size_t)u.e * D + col0 + bj * 8 + 4 * n);
#pragma unroll
        for (int ai = 0; ai < 2; ++ai)
#pragma unroll
            for (int m = 0; m < 4; ++m) { unsigned char* rowp = Y + (size_t)(row0 + ai * 128 + m * 16) * D + col0;
                const f32x4 v00 = acc[ai][0][m][0] + bv[0][0], v01 = acc[ai][0][m][1] + bv[0][1], v10 = acc[ai][1][m][0] + bv[1][0], v11 = acc[ai][1][m][1] + bv[1][1];
                v4u w; w.x = pk4_fp8(v00[0], v00[1], v00[2], v00[3]); w.y = pk4_fp8(v01[0], v01[1], v01[2], v01[3]); w.z = pk4_fp8(v10[0], v10[1], v10[2], v10[3]); w.w = pk4_fp8(v11[0], v11[1], v11[2], v11[3]);
                *(v4u*)rowp = w; }
    }
};

__device__ __forceinline__ void p0_transpose_item(const float* W, int K, int N, bf16* WT, LAS float* scr, int item, int lane) {
    const int nblk = N / 32, kb = item / nblk, nb = item % nblk, k0 = 64 * kb, n0 = 32 * nb;
#pragma unroll 8
    for (int i = 0; i < 32; ++i) { const int kk = 2 * i + (lane >> 5); scr[kk * 33 + (lane & 31)] = W[(size_t)(k0 + kk) * N + n0 + (lane & 31)]; }
    LDS_WAIT(); asm volatile("" ::: "memory");
    const int c = lane & 7;
#pragma unroll
    for (int j = 0; j < 4; ++j) { const int n = (lane >> 3) + 8 * j; const LAS float* s = scr + (8 * c) * 33 + n;
        v4u o; o.x = pk2(s[0 * 33], s[1 * 33]); o.y = pk2(s[2 * 33], s[3 * 33]); o.z = pk2(s[4 * 33], s[5 * 33]); o.w = pk2(s[6 * 33], s[7 * 33]);
        *(v4u*)(WT + (size_t)(n0 + n) * K + k0 + 8 * c) = o; }
    LDS_WAIT(); asm volatile("" ::: "memory");
}
struct Cvt64 { f32x4 v[16]; };
__device__ __forceinline__ void cvt64_load(Cvt64& q, const float* W, int N, int item, int lane) {
    const int nblk = N / 64, kb = item / nblk, nb = item % nblk, k0 = 64 * kb, n0 = 64 * nb, c4 = lane & 15, kr = lane >> 4;
#pragma unroll
    for (int i = 0; i < 16; ++i) q.v[i] = __builtin_nontemporal_load((const f32x4*)(W + (size_t)(k0 + 4 * i + kr) * N + n0 + 4 * c4));
}
__device__ __forceinline__ void cvt64_store(const Cvt64& q, int K, int N, unsigned char* WT, LAS float* scr, int item, int lane, const float* kscale = nullptr) {
    const int nblk = N / 64, kb = item / nblk, nb = item % nblk, k0 = 64 * kb, n0 = 64 * nb, c4 = lane & 15, kr = lane >> 4;
#pragma unroll
    for (int i = 0; i < 16; ++i) { const int k = 4 * i + kr; const float sc = kscale ? 64.f * kscale[k0 + k] : 64.f;
        *(LAS f32x4*)(scr + k * 64 + 4 * (c4 ^ (k & 15) ^ ((k >> 4) << 2))) = q.v[i] * sc; }
    LDS_WAIT(); asm volatile("" ::: "memory");
    const int kc = lane & 3;
#pragma unroll
    for (int j = 0; j < 4; ++j) { const int n = (lane >> 2) + 16 * j; float f[16];
#pragma unroll
        for (int i = 0; i < 16; ++i) { const int k = 16 * kc + i; f[i] = scr[k * 64 + 4 * ((n >> 2) ^ (k & 15) ^ ((k >> 4) << 2)) + (n & 3)]; }
        v4u o; o.x = pk4_fp8(f[0], f[1], f[2], f[3]); o.y = pk4_fp8(f[4], f[5], f[6], f[7]); o.z = pk4_fp8(f[8], f[9], f[10], f[11]); o.w = pk4_fp8(f[12], f[13], f[14], f[15]);
        *(v4u*)(WT + (size_t)(n0 + n) * K + k0 + 16 * kc) = o; }
    LDS_WAIT(); asm volatile("" ::: "memory");
}
__device__ __forceinline__ void p0_transpose_item_fp8(const float* W, int K, int N, unsigned char* WT, LAS float* scr, int item, int lane) {
    const int nblk = N / 32, kb = item / nblk, nb = item % nblk, k0 = 64 * kb, n0 = 32 * nb;
#pragma unroll 8
    for (int i = 0; i < 32; ++i) { const int kk = 2 * i + (lane >> 5); scr[kk * 33 + (lane & 31)] = W[(size_t)(k0 + kk) * N + n0 + (lane & 31)]; }
    LDS_WAIT(); asm volatile("" ::: "memory");
    const int c = lane & 3;
#pragma unroll
    for (int j = 0; j < 2; ++j) { const int n = (lane >> 2) + 16 * j; const LAS float* s = scr + (16 * c) * 33 + n;
        v4u o; o.x = pk4_fp8(64.f * s[0 * 33], 64.f * s[1 * 33], 64.f * s[2 * 33], 64.f * s[3 * 33]); o.y = pk4_fp8(64.f * s[4 * 33], 64.f * s[5 * 33], 64.f * s[6 * 33], 64.f * s[7 * 33]);
        o.z = pk4_fp8(64.f * s[8 * 33], 64.f * s[9 * 33], 64.f * s[10 * 33], 64.f * s[11 * 33]); o.w = pk4_fp8(64.f * s[12 * 33], 64.f * s[13 * 33], 64.f * s[14 * 33], 64.f * s[15 * 33]);
        *(v4u*)(WT + (size_t)(n0 + n) * K + k0 + 16 * c) = o; }
    LDS_WAIT(); asm volatile("" ::: "memory");
}
__device__ __forceinline__ void rms_row_to_bf16(const float* xrow, const float* g, bf16* orow, int lane, unsigned* orow8 = nullptr) {
    const f32x4* xr = (const f32x4*)xrow + lane; const f32x4* gr = (const f32x4*)g + lane;
    f32x4 v[8]; float s = 0.f;
#pragma unroll
    for (int j = 0; j < 8; ++j) { v[j] = __builtin_nontemporal_load(xr + 64 * j); s += (v[j].x * v[j].x + v[j].y * v[j].y) + (v[j].z * v[j].z + v[j].w * v[j].w); }
    const float rstd = 1.0f / sqrtf(wave_sum(s) * (1.f / D) + NORM_EPS);
    v2u* o8 = (v2u*)orow + lane;
#pragma unroll
    for (int j = 0; j < 8; ++j) { const f32x4 gg = gr[64 * j]; const float h0 = v[j].x * rstd * gg.x, h1 = v[j].y * rstd * gg.y, h2 = v[j].z * rstd * gg.z, h3 = v[j].w * rstd * gg.w;
        v2u w; w.x = pk2(h0, h1); w.y = pk2(h2, h3); o8[64 * j] = w; if (orow8) orow8[lane + 64 * j] = pk4_fp8(h0, h1, h2, h3); }
}

struct Args { const float* in[27]; float* out; unsigned char* ws; int ph_lo, ph_hi, li, pad; };
enum { I_X = 0, I_N1G, I_WIN, I_MU, I_W0, I_WDEC, I_A0, I_WICLR, I_WGATE, I_KK, I_KA, I_RK, I_LNG, I_LNB, I_BQKV, I_SINK, I_WUPR, I_WUPA, I_WOUT, I_N2G, I_WR, I_BR, I_W1, I_B1, I_W2, I_B2, I_NFG };
constexpr int NPHASE = 14;

__device__ __forceinline__ float dpp_xor1(float x) { return __builtin_bit_cast(float, __builtin_amdgcn_mov_dpp(__builtin_bit_cast(int, x), 0xB1, 0xF, 0xF, true)); }
__device__ __forceinline__ float dpp_xor2(float x) { return __builtin_bit_cast(float, __builtin_amdgcn_mov_dpp(__builtin_bit_cast(int, x), 0x4E, 0xF, 0xF, true)); }
__device__ __forceinline__ float dpp_hmir(float x) { return __builtin_bit_cast(float, __builtin_amdgcn_mov_dpp(__builtin_bit_cast(int, x), 0x141, 0xF, 0xF, true)); }
__device__ __forceinline__ float dpp_rmir(float x) { return __builtin_bit_cast(float, __builtin_amdgcn_mov_dpp(__builtin_bit_cast(int, x), 0x140, 0xF, 0xF, true)); }
__device__ __forceinline__ float red8(float x) { x += dpp_xor1(x); x += dpp_xor2(x); x += dpp_hmir(x); return x; }

__device__ __forceinline__ void cvt_experts(const Args& args, unsigned char* W1T, unsigned char* W2T, LAS float* scr, int lane, int first, int end, int stride) {
    constexpr int I_E1 = 32 * 64, I_E2 = 32 * 32;
#define CVT_SRC(it) ((it) < 32 * I_E1 ? args.in[I_W1] + (size_t)((it) / I_E1) * 2048 * 4096 : args.in[I_W2] + (size_t)(((it) - 32 * I_E1) / I_E2) * 2048 * 2048)
#define CVT_DST(it) ((it) < 32 * I_E1 ? W1T + (size_t)((it) / I_E1) * 4096 * 2048 : W2T + (size_t)(((it) - 32 * I_E1) / I_E2) * 2048 * 2048)
#define CVT_N(it) ((it) < 32 * I_E1 ? 4096 : 2048)
#define CVT_SUB(it) ((it) < 32 * I_E1 ? (it) % I_E1 : ((it) - 32 * I_E1) % I_E2)
    Cvt64 qa, qb; int ia = first, ib = first + stride;
    if (ia < end) cvt64_load(qa, CVT_SRC(ia), CVT_N(ia), CVT_SUB(ia), lane);
    while (ia < end) {
        if (ib < end) cvt64_load(qb, CVT_SRC(ib), CVT_N(ib), CVT_SUB(ib), lane);
        cvt64_store(qa, 2048, CVT_N(ia), CVT_DST(ia), scr, CVT_SUB(ia), lane, (ia < 32 * I_E1) ? args.in[I_N2G] : nullptr);
        ia = ib + stride;
        if (ib >= end) break;
        if (ia < end) cvt64_load(qa, CVT_SRC(ia), CVT_N(ia), CVT_SUB(ia), lane);
        cvt64_store(qb, 2048, CVT_N(ib), CVT_DST(ib), scr, CVT_SUB(ib), lane, (ib < 32 * I_E1) ? args.in[I_N2G] : nullptr);
        ib = ia + stride;
    }
#undef CVT_SRC
#undef CVT_DST
#undef CVT_N
#undef CVT_SUB
}

__global__ void __launch_bounds__(512, 2) fwd(Args args) {
    extern __shared__ __attribute__((aligned(16))) unsigned char lds_raw[];
    LAS unsigned char* lds = (LAS unsigned char*)lds_raw;
    volatile LAS unsigned* MISC = (volatile LAS unsigned*)(lds + MISC_OFF);
    LAS int* TAB = (LAS int*)(lds + TAB_OFF);
    const int tid = threadIdx.x, lane = tid & 63, wave = __builtin_amdgcn_readfirstlane(tid >> 6);
    const int G = gridDim.x, bx = blockIdx.x;
    const int vcu = (G % 8 == 0) ? (bx % 8) * (G / 8) + bx / 8 : bx;
    unsigned char* ws = args.ws;
    unsigned* ctl = (unsigned*)(ws + WS_CTL);
    for (int u = tid; u < 64; u += 512) MISC[u] = 0u;
    __syncthreads();
#if MK_N_LAUNCHES == 1
    XcdBarrier bar = xcd_barrier_post(ctl + CW_BAR + args.li * XCD_BAR_WORDS, MISC + 8);
#define GRID_BAR() xcd_barrier(bar)
#else
#define GRID_BAR() do {} while (0)
#endif
    const int lo = args.ph_lo, hi = args.ph_hi;
#define IN(k) (lo <= (k) && (k) < hi)
#define BOTH(k) (IN(k) && IN((k) + 1))
    const float* x = args.in[I_X];
    bf16* WinT = (bf16*)(ws + WS_WIN_T); bf16* WuprT = (bf16*)(ws + WS_WUPR_T); bf16* WupaT = (bf16*)(ws + WS_WUPA_T); bf16* WoutT = (bf16*)(ws + WS_WOUT_T);
    bf16* WdT = (bf16*)(ws + WS_WD_T); bf16* WiT = (bf16*)(ws + WS_WI_T); bf16* WgT = (bf16*)(ws + WS_WG_T);
    unsigned char* W1T = ws + WS_W1_T; unsigned char* W2T = ws + WS_W2_T;
    unsigned char* H8 = ws + WS_H;
    bf16* Hb = (bf16*)(ws + WS_H); bf16* Z = (bf16*)(ws + WS_Z);
    unsigned char* scb = ws + WS_SCAN;
    bf16* S_R = (bf16*)(scb + SC_R); bf16* S_KF = (bf16*)(scb + SC_KF); bf16* S_V = (bf16*)(scb + SC_V); bf16* S_AN = (bf16*)(scb + SC_AN); bf16* S_BN = (bf16*)(scb + SC_BN); bf16* S_G = (bf16*)(scb + SC_G);
    float* S_LW = (float*)(scb + SC_LW); bf16* S_QR = (bf16*)(scb + SC_QR); float* S_YL = (float*)(scb + SC_YL); bf16* S_E = (bf16*)(scb + SC_E); float* S_HP = (float*)(scb + SC_HP);
    bf16* PST = (bf16*)(ws + WS_PST); float* GAMg = (float*)(ws + WS_GAM); float* BDg = (float*)(ws + WS_BD);
    bf16* YR = (bf16*)(ws + WS_YR); bf16* YA = (bf16*)(ws + WS_YA); bf16* T1 = (bf16*)(ws + WS_T1); bf16* MG = (bf16*)(ws + WS_MG);
    unsigned char* ACT = ws + WS_ACT; unsigned char* Yb = ws + WS_Y;
    int* topi = (int*)(ws + WS_TOPI); float* topg = (float*)(ws + WS_TOPG); int* slotof = (int*)(ws + WS_SLOT);
    int* tokslot = (int*)(ctl + CW_TOKSLOT);
    bf16* X1 = (bf16*)(ws + WS_X1); bf16* WrS = (bf16*)(ws + WS_WRT); float* rss = (float*)(ctl + CW_RSS);
    float* rstd_tok = (float*)(ws + WS_BD);
    unsigned* cntw = ctl + CW_CNT + args.li * 256;
    const int gw = vcu * 8 + wave, NGW = G * 8;

    if (IN(0)) {
        LAS float* scr = (LAS float*)(lds + wave * 16384);
        constexpr int I_IN = 32 * 152, I_UP = 16 * 64, I_OUT = 32 * 64, I_E1 = 32 * 64, I_E2 = 32 * 32;
        constexpr int NITEMS = I_IN + 2 * I_UP + I_OUT + 128;
        for (int it = gw; it < NITEMS; it += NGW) {
            int r = it;
            if (r < I_IN) { p0_transpose_item(args.in[I_WIN], 2048, IN_COLS, WinT, scr, (r / 152) * 280 + (r % 152), lane); continue; } r -= I_IN;
            if (r < I_UP) { if (r < 16 * 32) { Cvt64 q; cvt64_load(q, args.in[I_WUPR], 2048, r, lane); cvt64_store(q, 1024, 2048, (unsigned char*)WuprT, scr, r, lane); } continue; } r -= I_UP;
            if (r < I_UP) { if (r < 16 * 32) { Cvt64 q; cvt64_load(q, args.in[I_WUPA], 2048, r, lane); cvt64_store(q, 1024, 2048, (unsigned char*)WupaT, scr, r, lane); } continue; } r -= I_UP;
            if (r < I_OUT) { if (r < 32 * 32) { Cvt64 q; cvt64_load(q, args.in[I_WOUT], 2048, r, lane); cvt64_store(q, 2048, 2048, (unsigned char*)WoutT, scr, r, lane); } continue; } r -= I_OUT;
            if (r < 32) { p0_transpose_item(args.in[I_WDEC], 64, 1024, WdT, scr, r, lane); continue; } r -= 32;
            if (r < 32) { p0_transpose_item(args.in[I_WICLR], 64, 1024, WiT, scr, r, lane); continue; } r -= 32;
            p0_transpose_item(args.in[I_WGATE], 128, 1024, WgT, scr, r, lane);
        }
        for (int it = gw; it < 32 * 64; it += NGW) { Cvt64 q; const int item = (it >> 6) * (IN_COLS / 64) + (it & 63);
            cvt64_load(q, args.in[I_WIN] + ZC_GR, IN_COLS, item, lane); cvt64_store(q, 2048, IN_COLS, ws + WS_WING, scr, item, lane); }
        for (int i = bx * 512 + tid; i < 32 * 2048; i += G * 512) { const int e = i >> 11, k = i & 2047; const float w = args.in[I_N2G][k] * args.in[I_WR][k * 32 + e];
            const unsigned h = f2bf(w); const float r1 = w - __builtin_bit_cast(float, h << 16); const unsigned m = f2bf(r1); const float r2 = r1 - __builtin_bit_cast(float, m << 16);
            WrS[i] = (bf16)h; WrS[65536 + i] = (bf16)m; WrS[131072 + i] = (bf16)f2bf(r2); }
        for (int m = gw; m < NT; m += NGW) rms_row_to_bf16(x + (size_t)m * D, args.in[I_N1G], Hb + (size_t)m * D, lane, (unsigned*)(ws + WS_H1F + (size_t)m * D));
        if (BOTH(0)) GRID_BAR();
    }
    if (IN(1)) {
        const bool split = (G % 16 == 0);
        const int role = split ? ((bx >> 3) & 1) : 0, rank = split ? ((bx >> 4) * 8 + (bx & 7)) : bx, GG = split ? G / 2 : G;
        const int cfirst = (split ? rank : vcu) * 8 + wave, cstride = GG * 8;
        constexpr int NEI = 32 * 32 * 64 + 32 * 32 * 32, NEI1 = 92 * 1024;
        const int nei1 = split ? NEI1 : NEI;
        if (!split || role == 1) cvt_experts(args, W1T, W2T, (LAS float*)(lds + wave * 16384), lane, cfirst, nei1, cstride);
        if (!split || role == 1) { __syncthreads(); ProbInG Pg; Pg.K = 2048; Pg.S.init(NT, IN_COLS - ZC_GR, GG, rank, 0, 0); Pg.A = ws + WS_H1F; Pg.Bt = ws + WS_WING; Pg.Z = Z; pg8::gemm_phase(lds, Pg); }
        if (!split || role == 0) { ProbIn P; P.K = 2048; P.S.init(NT, ZC_GR, GG, rank); P.A = Hb; P.Bt = WinT; P.Z = Z; P.bqkv = args.in[I_BQKV]; pg8::gemm_phase(lds, P);
            if (split) { __syncthreads(); cvt_experts(args, W1T, W2T, (LAS float*)(lds + wave * 16384), lane, NEI1 + cfirst, NEI, cstride); } }
        if (BOTH(1)) GRID_BAR();
    }
    if (IN(2)) {
        {
            constexpr int XS = 528;
            LAS unsigned char* XL = lds; LAS float* NRM = (LAS float*)(lds + 64 * XS);
            LAS float* PRM = (LAS float*)(lds + 40960);
            for (int idx = tid; idx < 7 * 1024; idx += 512) { const int ar = idx >> 10, c = idx & 1023;
                PRM[idx] = ar == 0 ? args.in[I_W0][c] : ar == 1 ? args.in[I_A0][c] : ar == 2 ? args.in[I_KK][c] : ar == 3 ? args.in[I_KA][c] : ar == 4 ? args.in[I_MU][ZC_R + c] : ar == 5 ? args.in[I_MU][ZC_K + c] : args.in[I_MU][ZC_V + c]; }
            const float* mu = args.in[I_MU]; const float* kkp = args.in[I_KK];
            const int fr = lane & 15, fq = lane >> 4;
            for (int un = bx; un < NT / 64; un += G) {
                const size_t t0 = (size_t)un * 64;
                __syncthreads();
#pragma unroll
                for (int i = 0; i < 4; ++i) {
                    const int idx = tid + 512 * i, tok = idx >> 5, c8 = idx & 31, col = ZC_LORA + 8 * c8; const size_t t = t0 + tok;
                    const v4u cw = *(const v4u*)(Z + t * IN_COLS + col); v4u pw = (v4u){0u, 0u, 0u, 0u}; if (t % SEQ != 0) pw = *(const v4u*)(Z + (t - 1) * IN_COLS + col);
                    const f32x4 m0 = *(const f32x4*)(mu + col), m1 = *(const f32x4*)(mu + col + 4);
                    float xv[8]; const unsigned cu[4] = {cw.x, cw.y, cw.z, cw.w}, pu[4] = {pw.x, pw.y, pw.z, pw.w};
#pragma unroll
                    for (int j = 0; j < 4; ++j) { const float ml = j < 2 ? m0[2 * j] : m1[2 * j - 4], mh = j < 2 ? m0[2 * j + 1] : m1[2 * j - 3];
                        xv[2 * j] = bflo(cu[j]) + (bflo(pu[j]) - bflo(cu[j])) * ml; xv[2 * j + 1] = bfhi(cu[j]) + (bfhi(pu[j]) - bfhi(cu[j])) * mh; }
                    if (c8 < 8) {
#pragma unroll
                        for (int j = 0; j < 8; ++j) xv[j] = 1.0f - 2.0f * __builtin_amdgcn_rcpf(1.0f + __expf(2.0f * xv[j])); }
                    else if (c8 >= 16) {
#pragma unroll
                        for (int j = 0; j < 8; ++j) xv[j] = sigmoidf_(xv[j]); }
                    *(LAS v4u*)(XL + tok * XS + c8 * 16) = (v4u){pk2(xv[0], xv[1]), pk2(xv[2], xv[3]), pk2(xv[4], xv[5]), pk2(xv[6], xv[7])};
                }
#pragma unroll 4
                for (int i = 0; i < 16; ++i) {
                    const int pr = (tid >> 3) + 64 * i, tok = pr >> 4, hd = pr & 15, ch = hd * 64 + 8 * (tid & 7); const size_t t = t0 + tok;
                    const v4u cw = *(const v4u*)(Z + t * IN_COLS + ZC_K + ch); v4u pw = (v4u){0u, 0u, 0u, 0u}; if (t % SEQ != 0) pw = *(const v4u*)(Z + (t - 1) * IN_COLS + ZC_K + ch);
                    const LAS float* pp = PRM + ch;
                    const f32x4 m0 = *(const LAS f32x4*)(pp + 5120), m1 = *(const LAS f32x4*)(pp + 5124), k0 = *(const LAS f32x4*)(pp + 2048), k1 = *(const LAS f32x4*)(pp + 2052);
                    const unsigned cu[4] = {cw.x, cw.y, cw.z, cw.w}, pu[4] = {pw.x, pw.y, pw.z, pw.w};
                    float ss = 0.f;
#pragma unroll
                    for (int j = 0; j < 4; ++j) { const float ml = j < 2 ? m0[2 * j] : m1[2 * j - 4], mh = j < 2 ? m0[2 * j + 1] : m1[2 * j - 3], kl = j < 2 ? k0[2 * j] : k1[2 * j - 4], kh = j < 2 ? k0[2 * j + 1] : k1[2 * j - 3];
                        const float a = (bflo(cu[j]) + (bflo(pu[j]) - bflo(cu[j])) * ml) * kl, bq = (bfhi(cu[j]) + (bfhi(pu[j]) - bfhi(cu[j])) * mh) * kh; ss += a * a + bq * bq; }
                    ss = red8(ss);
                    if ((tid & 7) == 0) NRM[tok * 16 + hd] = 1.0f / fmaxf(sqrtf(ss), 1e-12f);
                }
                __syncthreads();
                for (int cp = 0; cp < 4; ++cp) {
                    const int c0 = 128 * wave + 32 * cp, hd = c0 >> 6, ch8 = c0 + 8 * fq;
                    bf16x8 wd[2][2], wi[2][2], wg[2][4];
#pragma unroll
                    for (int ab = 0; ab < 2; ++ab) { const int chr = c0 + 8 * (fr >> 2) + 4 * ab + (fr & 3);
#pragma unroll
                        for (int ks = 0; ks < 2; ++ks) { wd[ab][ks] = *(const bf16x8*)(WdT + chr * 64 + 32 * ks + 8 * fq); wi[ab][ks] = *(const bf16x8*)(WiT + chr * 64 + 32 * ks + 8 * fq); }
#pragma unroll
                        for (int ks = 0; ks < 4; ++ks) wg[ab][ks] = *(const bf16x8*)(WgT + chr * 128 + 32 * ks + 8 * fq); }
                    v4u zpf[2][4];
#define PREP_ZLOAD(q, tt_) do { const size_t t_ = t0 + 16 * (tt_) + fr; const bf16* zr_ = Z + t_ * IN_COLS + ch8; \
                        q[0] = *(const v4u*)(zr_ + ZC_K); q[1] = *(const v4u*)(zr_ + ZC_V); q[2] = (v4u){0u, 0u, 0u, 0u}; q[3] = q[2]; \
                        if (t_ % SEQ != 0) { q[2] = *(const v4u*)(zr_ - IN_COLS + ZC_K); q[3] = *(const v4u*)(zr_ - IN_COLS + ZC_V); } } while (0)
                    PREP_ZLOAD(zpf[0], 0);
#pragma unroll
                    for (int tt = 0; tt < 4; ++tt) {
                        asm volatile("" ::: "memory");
                        if (tt + 1 < 4) PREP_ZLOAD(zpf[(tt + 1) & 1], tt + 1);
                        asm volatile("" ::: "memory");
                        const int tok = 16 * tt + fr; const size_t t = t0 + tok;
                        f32x4 dw[2], da[2], dg[2];
#pragma unroll
                        for (int ab = 0; ab < 2; ++ab) { dw[ab] = (f32x4){0.f, 0.f, 0.f, 0.f}; da[ab] = dw[ab]; dg[ab] = dw[ab]; }
#pragma unroll
                        for (int ks = 0; ks < 8; ++ks) { const bf16x8 xb = *(const LAS bf16x8*)(XL + tok * XS + (32 * ks + 8 * fq) * 2);
#pragma unroll
                            for (int ab = 0; ab < 2; ++ab) {
                                if (ks < 2) dw[ab] = __builtin_amdgcn_mfma_f32_16x16x32_bf16(wd[ab][ks], xb, dw[ab], 0, 0, 0);
                                else if (ks < 4) da[ab] = __builtin_amdgcn_mfma_f32_16x16x32_bf16(wi[ab][ks - 2], xb, da[ab], 0, 0, 0);
                                else dg[ab] = __builtin_amdgcn_mfma_f32_16x16x32_bf16(wg[ab][ks - 4], xb, dg[ab], 0, 0, 0); } }
                        const v4u ck4 = zpf[tt & 1][0], cv4 = zpf[tt & 1][1], pk4 = zpf[tt & 1][2], pv4 = zpf[tt & 1][3];
                        const float inrm = NRM[tok * 16 + hd];
                        unsigned q_kf[4], q_v[4], q_an[4], q_bn[4], q_g[4]; float o_lw[8];
#pragma unroll
                        for (int ab = 0; ab < 2; ++ab) {
                            asm volatile("" ::: "memory");
                            const LAS float* pp = PRM + ch8 + 4 * ab;
                            const f32x4 pw0 = *(const LAS f32x4*)(pp), pa0 = *(const LAS f32x4*)(pp + 1024), pkk = *(const LAS f32x4*)(pp + 2048), pka = *(const LAS f32x4*)(pp + 3072),
                                        pmk = *(const LAS f32x4*)(pp + 5120), pmv = *(const LAS f32x4*)(pp + 6144);
                            const unsigned cku[2] = {ab ? ck4.z : ck4.x, ab ? ck4.w : ck4.y}, cvu[2] = {ab ? cv4.z : cv4.x, ab ? cv4.w : cv4.y}, pku[2] = {ab ? pk4.z : pk4.x, ab ? pk4.w : pk4.y}, pvu[2] = {ab ? pv4.z : pv4.x, ab ? pv4.w : pv4.y};
                            float e_kf[4], e_v[4], e_an[4], e_bn[4];
#pragma unroll
                            for (int j = 0; j < 4; ++j) { const int w = j >> 1; const bool hi = j & 1;
                                const float kc = hi ? bfhi(cku[w]) : bflo(cku[w]), kp2 = hi ? bfhi(pku[w]) : bflo(pku[w]), vc = hi ? bfhi(cvu[w]) : bflo(cvu[w]), vp2 = hi ? bfhi(pvu[w]) : bflo(pvu[w]);
                                const float kx = kc + (kp2 - kc) * pmk[j];
                                const float a = sigmoidf_(pa0[j] + da[ab][j]); const float kk = kx * pkk[j] * inrm;
                                o_lw[4 * ab + j] = -0.60653066f * sigmoidf_(pw0[j] + dw[ab][j]);
                                e_kf[j] = kx * (1.0f + (a - 1.0f) * pka[j]); e_v[j] = vc + (vp2 - vc) * pmv[j]; e_an[j] = -kk; e_bn[j] = kk * a; }
                            q_kf[2 * ab] = pk2(e_kf[0], e_kf[1]); q_kf[2 * ab + 1] = pk2(e_kf[2], e_kf[3]);
                            q_v[2 * ab] = pk2(e_v[0], e_v[1]); q_v[2 * ab + 1] = pk2(e_v[2], e_v[3]); q_an[2 * ab] = pk2(e_an[0], e_an[1]); q_an[2 * ab + 1] = pk2(e_an[2], e_an[3]);
                            q_bn[2 * ab] = pk2(e_bn[0], e_bn[1]); q_bn[2 * ab + 1] = pk2(e_bn[2], e_bn[3]); q_g[2 * ab] = pk2(dg[ab][0], dg[ab][1]); q_g[2 * ab + 1] = pk2(dg[ab][2], dg[ab][3]);
                        }
                        const size_t o = t * C + ch8;
                        *(v4u*)(S_KF + o) = (v4u){q_kf[0], q_kf[1], q_kf[2], q_kf[3]}; *(v4u*)(S_V + o) = (v4u){q_v[0], q_v[1], q_v[2], q_v[3]};
                        *(v4u*)(S_AN + o) = (v4u){q_an[0], q_an[1], q_an[2], q_an[3]}; *(v4u*)(S_BN + o) = (v4u){q_bn[0], q_bn[1], q_bn[2], q_bn[3]}; *(v4u*)(S_G + o) = (v4u){q_g[0], q_g[1], q_g[2], q_g[3]};
                        *(v4u*)((bf16*)S_LW + o) = (v4u){pk2(o_lw[0], o_lw[1]), pk2(o_lw[2], o_lw[3]), pk2(o_lw[4], o_lw[5]), pk2(o_lw[6], o_lw[7])};
                    }
                }
            }
        }
#undef PREP_ZLOAD
        if (BOTH(2)) GRID_BAR();
    }
    if (IN(3)) {
        constexpr int MS = 144;
        constexpr int LA_R = 0, LA_B = 9216, LA_AT = 18432, LA_BT = 27648, LA_ARB = 36864, LA_AKVT = 46080,
                      LA_AABH = 55296  , LA_DG = 64512  , LA_DH = 69632  ,
                      LA_GAM = 72704, LA_A = 73728, LA_K = 82944, LA_KT = 92160, LA_VT = 101376, LA_AAK = 110592, LA_ARK = 119808, LA_SEG = LA_AABH;
        const int rb = wave >> 1, cb0 = 2 * (wave & 1);
#define FRAG(off, row, kb) (*(const LAS bf16x8*)(lds + (off) + (row) * MS + (kb)))
#define PROD2(acc, XO, YO) do { _Pragma("unroll") for (int ks = 0; ks < 2; ++ks) { const bf16x8 a_ = FRAG(XO, 16 * rb + fr, 16 * fq + 64 * ks); \
            _Pragma("unroll") for (int n = 0; n < 2; ++n) { const bf16x8 b_ = FRAG(YO, 16 * (cb0 + n) + fr, 16 * fq + 64 * ks); acc[n] = __builtin_amdgcn_mfma_f32_16x16x32_bf16(a_, b_, acc[n], 0, 0, 0); } } } while (0)
        const float* rkp = args.in[I_RK];
        bf16 pr_[9], pk_[8], pv_[8], pa_[8], pb_[8], pl_[8];
        if (bx < 512 * 16) { const size_t g0 = ((size_t)(bx >> 4) * 64 + 8 * wave) * C + (bx & 15) * 64 + lane;
            { const size_t tr0 = (size_t)(bx >> 4) * 64 + 8 * wave; const int cz = ZC_R + (bx & 15) * 64 + lane;
#pragma unroll
              for (int j = 0; j < 9; ++j) pr_[j] = ((tr0 + j) % SEQ == 0 && j == 0) ? (bf16)0 : Z[(tr0 + j - 1) * IN_COLS + cz]; }
#pragma unroll
            for (int j = 0; j < 8; ++j) { const size_t o = g0 + (size_t)j * C; pk_[j] = S_KF[o]; pv_[j] = S_V[o]; pa_[j] = S_AN[o]; pb_[j] = S_BN[o]; pl_[j] = ((const bf16*)S_LW)[o]; } }
        for (int un = bx; un < 512 * 16; un += G) {
            const int h = un & 15, tb = un >> 4; const size_t t0 = (size_t)tb * 64;
            int ln = lane; asm volatile("" : "+v"(ln));
            const int fr = ln & 15, fq = ln >> 4;
            __syncthreads();
            {
                float r8[8], k8[8], v8[8], a8[8], b8[8], lw8[8], cs[8];
                const float mur_ = args.in[I_MU][ZC_R + h * 64 + ln], rkv = rkp[h * 64 + ln];
#pragma unroll
                for (int j = 0; j < 8; ++j) { const float rc_ = bf1(pr_[j + 1]), rp_ = bf1(pr_[j]); r8[j] = rc_ + (rp_ - rc_) * mur_; k8[j] = bf1(pk_[j]); v8[j] = bf1(pv_[j]); a8[j] = bf1(pa_[j]); b8[j] = bf1(pb_[j]); lw8[j] = bf1(pl_[j]); }
                {
                    const int un2 = (un + G < 512 * 16) ? un + G : un;
                    const size_t g2 = ((size_t)(un2 >> 4) * 64 + 8 * wave) * C + (un2 & 15) * 64 + ln;
                    { const size_t tr2 = (size_t)(un2 >> 4) * 64 + 8 * wave; const int cz2 = ZC_R + (un2 & 15) * 64 + ln;
#pragma unroll
                      for (int j = 0; j < 9; ++j) pr_[j] = ((tr2 + j) % SEQ == 0 && j == 0) ? (bf16)0 : Z[(tr2 + j - 1) * IN_COLS + cz2]; }
#pragma unroll
                    for (int j = 0; j < 8; ++j) { const size_t o = g2 + (size_t)j * C; pk_[j] = S_KF[o]; pv_[j] = S_V[o]; pa_[j] = S_AN[o]; pb_[j] = S_BN[o]; pl_[j] = ((const bf16*)S_LW)[o]; }
                }
                cs[0] = lw8[0];
#pragma unroll
                for (int j = 1; j < 8; ++j) cs[j] = cs[j - 1] + lw8[j];
                ((LAS float*)(lds + LA_SEG))[wave * 64 + ln] = cs[7];
                {
                    float x4[4], x2[2], x1;
                    const bool b0 = ln & 1, b1 = ln & 2, b2 = ln & 4;
#pragma unroll
                    for (int i = 0; i < 4; ++i) { const float e = r8[2 * i] * k8[2 * i] * rkv, o = r8[2 * i + 1] * k8[2 * i + 1] * rkv; x4[i] = (b0 ? o : e) + dpp_xor1(b0 ? e : o); }
#pragma unroll
                    for (int i = 0; i < 2; ++i) { const float e = x4[2 * i], o = x4[2 * i + 1]; x2[i] = (b1 ? o : e) + dpp_xor2(b1 ? e : o); }
                    { const float e = x2[0], o = x2[1]; x1 = (b2 ? o : e) + __shfl_xor(b2 ? e : o, 4); }
                    x1 += __shfl_xor(x1, 8); x1 += __shfl_xor(x1, 16); x1 += __shfl_xor(x1, 32);
                    if (ln < 8) BDg[(t0 + 8 * wave + ln) * 16 + h] = x1;
                }
                __syncthreads();
                float pre = 0.f, tot = 0.f;
#pragma unroll
                for (int s = 0; s < 8; ++s) { const float xx = ((LAS float*)(lds + LA_SEG))[s * 64 + ln]; tot += xx; pre += (s < wave) ? xx : 0.f; }
                unsigned pa[4], pb[4], pk[4], pv[4];
#pragma unroll
                for (int j2 = 0; j2 < 4; ++j2) {
                    float Rf[2], Af[2], Bf[2], Kf[2];
#pragma unroll
                    for (int u = 0; u < 2; ++u) { const int j = 2 * j2 + u; const float cum = pre + cs[j], ec = __expf(cum), en = __expf(-cum), ep = __expf(cum - lw8[j]);
                        Rf[u] = r8[j] * ec; Af[u] = a8[j] * ep; Bf[u] = b8[j] * en; Kf[u] = k8[j] * en; }
                    const unsigned Rw = pk2(Rf[0], Rf[1]), Aw = pk2(Af[0], Af[1]), Bw = pk2(Bf[0], Bf[1]), Kw = pk2(Kf[0], Kf[1]);
                    pa[j2] = Aw; pb[j2] = Bw; pk[j2] = Kw; pv[j2] = (__builtin_bit_cast(unsigned, v8[2 * j2]) >> 16) | (__builtin_bit_cast(unsigned, v8[2 * j2 + 1]) & 0xffff0000u);
                    const int t = 8 * wave + 2 * j2;
                    *(LAS bf16*)(lds + LA_R + t * MS + ln * 2) = (bf16)(Rw & 0xffffu); *(LAS bf16*)(lds + LA_R + (t + 1) * MS + ln * 2) = (bf16)(Rw >> 16);
                    *(LAS bf16*)(lds + LA_A + t * MS + ln * 2) = (bf16)(Aw & 0xffffu); *(LAS bf16*)(lds + LA_A + (t + 1) * MS + ln * 2) = (bf16)(Aw >> 16);
                    *(LAS bf16*)(lds + LA_B + t * MS + ln * 2) = (bf16)(Bw & 0xffffu); *(LAS bf16*)(lds + LA_B + (t + 1) * MS + ln * 2) = (bf16)(Bw >> 16);
                    *(LAS bf16*)(lds + LA_K + t * MS + ln * 2) = (bf16)(Kw & 0xffffu); *(LAS bf16*)(lds + LA_K + (t + 1) * MS + ln * 2) = (bf16)(Kw >> 16);
                }
                *(LAS v4u*)(lds + LA_AT + ln * MS + wave * 16) = (v4u){pa[0], pa[1], pa[2], pa[3]};
                *(LAS v4u*)(lds + LA_BT + ln * MS + wave * 16) = (v4u){pb[0], pb[1], pb[2], pb[3]};
                *(LAS v4u*)(lds + LA_KT + ln * MS + wave * 16) = (v4u){pk[0], pk[1], pk[2], pk[3]};
                *(LAS v4u*)(lds + LA_VT + ln * MS + wave * 16) = (v4u){pv[0], pv[1], pv[2], pv[3]};
                if (wave == 0) { const float gl = __expf(tot); ((LAS float*)(lds + LA_GAM))[ln] = gl; GAMg[(size_t)un * 64 + ln] = gl; }
            }
            __syncthreads();
            {
                f32x4 cab[2], cak[2], crb[2], crk[2];
#pragma unroll
                for (int n = 0; n < 2; ++n) { cab[n] = (f32x4){0.f, 0.f, 0.f, 0.f}; cak[n] = cab[n]; crb[n] = cab[n]; crk[n] = cab[n]; }
#pragma unroll
                for (int ks = 0; ks < 2; ++ks) { const bf16x8 aA = FRAG(LA_A, 16 * rb + fr, 16 * fq + 64 * ks), aR = FRAG(LA_R, 16 * rb + fr, 16 * fq + 64 * ks);
#pragma unroll
                    for (int n = 0; n < 2; ++n) { const bf16x8 bB = FRAG(LA_B, 16 * (cb0 + n) + fr, 16 * fq + 64 * ks), bK = FRAG(LA_K, 16 * (cb0 + n) + fr, 16 * fq + 64 * ks);
                        cab[n] = __builtin_amdgcn_mfma_f32_16x16x32_bf16(aA, bB, cab[n], 0, 0, 0); cak[n] = __builtin_amdgcn_mfma_f32_16x16x32_bf16(aA, bK, cak[n], 0, 0, 0);
                        crb[n] = __builtin_amdgcn_mfma_f32_16x16x32_bf16(aR, bB, crb[n], 0, 0, 0); crk[n] = __builtin_amdgcn_mfma_f32_16x16x32_bf16(aR, bK, crk[n], 0, 0, 0); } }
#pragma unroll
                for (int n = 0; n < 2; ++n)
#pragma unroll
                    for (int rg = 0; rg < 4; ++rg) { const int t = 16 * rb + 4 * fq + rg, s = 16 * (cb0 + n) + fr;
                        const float vab = (s < t) ? cab[n][rg] : 0.f;
                        *(LAS bf16*)(lds + LA_AABH + t * MS + s * 2) = (bf16)f2bf(vab);
                        if (rb == cb0 + n) ((LAS float*)(lds + LA_DG))[rb * 320 + (4 * fq + rg) * 20 + fr] = vab;
                        *(LAS bf16*)(lds + LA_AAK + t * MS + s * 2) = (bf16)((s < t) ? f2bf(cak[n][rg]) : 0u);
                        *(LAS bf16*)(lds + LA_ARB + t * MS + s * 2) = (bf16)((s <= t) ? f2bf(crb[n][rg]) : 0u);
                        *(LAS bf16*)(lds + LA_ARK + t * MS + s * 2) = (bf16)((s <= t) ? f2bf(crk[n][rg]) : 0u); }
            }
            __syncthreads();
            f32x4 accY[2], accH[2];
            {
                f32x4 ckv[2];
#pragma unroll
                for (int n = 0; n < 2; ++n) { ckv[n] = (f32x4){0.f, 0.f, 0.f, 0.f}; accY[n] = ckv[n]; accH[n] = ckv[n]; }
                PROD2(ckv, LA_AAK, LA_VT); PROD2(accY, LA_ARK, LA_VT); PROD2(accH, LA_KT, LA_VT);
#pragma unroll
                for (int n = 0; n < 2; ++n) { v2u w; w.x = pk2(ckv[n][0], ckv[n][1]); w.y = pk2(ckv[n][2], ckv[n][3]);
                    *(LAS v2u*)(lds + LA_AKVT + (16 * (cb0 + n) + fr) * MS + (16 * rb + 4 * fq) * 2) = w; }
                if (wave == 7) {
                    const int blk = ln >> 4, cc = ln & 15; const LAS float* Ad = (const LAS float*)(lds + LA_DG) + blk * 320;
                    float wc[16];
#pragma unroll
                    for (int t = 0; t < 16; ++t) { float a_ = (t == cc) ? 1.0f : 0.0f;
#pragma unroll
                        for (int s4 = 0; s4 < (t + 3) / 4; ++s4) { const f32x4 av = *(const LAS f32x4*)(Ad + t * 20 + s4 * 4);
#pragma unroll
                            for (int q = 0; q < 4; ++q) if (s4 * 4 + q < t) a_ += av[q] * wc[s4 * 4 + q]; }
                        wc[t] = a_; }
#pragma unroll
                    for (int t = 0; t < 16; ++t) *(LAS bf16*)(lds + LA_DH + blk * 768 + t * 48 + cc * 2) = (bf16)f2bf(wc[t]);
                }
            }
            __syncthreads();
            {
                LAS unsigned char* xb = lds + (wave < 4 ? LA_AT + 16 * wave * MS : LA_AKVT + 16 * (wave - 4) * MS);
                const bf16x8 zf = (bf16x8){0, 0, 0, 0, 0, 0, 0, 0};
#pragma unroll
                for (int i = 0; i < 4; ++i) {
                    LAS unsigned char* zp = xb + fr * MS + (16 * i + 4 * fq) * 2;
                    const v2u xw = *(const LAS v2u*)zp;
                    f32x4 y = (f32x4){bflo(xw.x), bfhi(xw.x), bflo(xw.y), bfhi(xw.y)};
#pragma unroll
                    for (int ks = 0; ks < (i + 1) / 2; ++ks) {
                        const bool live = (8 * fq + 32 * ks) < 16 * i;
                        bf16x8 a_ = FRAG(LA_AABH, 16 * i + fr, 16 * fq + 64 * ks), b_ = *(const LAS bf16x8*)(xb + fr * MS + 16 * fq + 64 * ks);
                        if (!live) { a_ = zf; b_ = zf; }
                        y = __builtin_amdgcn_mfma_f32_16x16x32_bf16(a_, b_, y, 0, 0, 0);
                    }
                    v2u yw; yw.x = pk2(y[0], y[1]); yw.y = pk2(y[2], y[3]);
                    const v2u dw = *(const LAS v2u*)(lds + LA_DH + i * 768 + fr * 48 + fq * 8);
                    const f32x4 z = __builtin_amdgcn_mfma_f32_16x16x16bf16_1k(__builtin_bit_cast(s16x4, dw), __builtin_bit_cast(s16x4, yw), (f32x4){0.f, 0.f, 0.f, 0.f}, 0, 0, 0);
                    v2u zw; zw.x = pk2(z[0], z[1]); zw.y = pk2(z[2], z[3]);
                    *(LAS v2u*)zp = zw;
                    asm volatile("s_waitcnt lgkmcnt(0)" ::: "memory");
                }
            }
            __syncthreads();
            {
                PROD2(accY, LA_ARB, LA_AKVT);
                PROD2(accH, LA_BT, LA_AKVT);
                f32x4 cE[2], cQ[2];
#pragma unroll
                for (int n = 0; n < 2; ++n) { cE[n] = (f32x4){0.f, 0.f, 0.f, 0.f};
                    const v2u rr = *(const LAS v2u*)(lds + LA_R + (16 * (cb0 + n) + fr) * MS + (16 * rb + 4 * fq) * 2);
                    cQ[n] = (f32x4){bflo(rr.x), bfhi(rr.x), bflo(rr.y), bfhi(rr.y)}; }
                PROD2(cE, LA_AT, LA_BT);
                PROD2(cQ, LA_AT, LA_ARB);
                const size_t ib = (size_t)un * 4096;
#pragma unroll
                for (int n = 0; n < 2; ++n) {
                    { v2u wy; wy.x = pk2(accY[n][0], accY[n][1]); wy.y = pk2(accY[n][2], accY[n][3]); *(v2u*)((bf16*)S_YL + ib + (size_t)(((rb * 4 + cb0 + n) * 64 + ln) * 4)) = wy; }
                    const float gj = ((const LAS float*)(lds + LA_GAM))[16 * (cb0 + n) + fr];
                    f32x4 gv;
#pragma unroll
                    for (int rg = 0; rg < 4; ++rg) gv[rg] = gj * (cE[n][rg] + ((16 * (cb0 + n) + fr) == (16 * rb + 4 * fq + rg) ? 1.0f : 0.0f));
                    v2u we; we.x = pk2(gv[0], gv[1]); we.y = pk2(gv[2], gv[3]);
                    *(v2u*)(S_E + ib + (size_t)((16 * (cb0 + n) + fr) * 64 + 16 * rb + 4 * fq)) = we;
                    v2u wq; wq.x = pk2(cQ[n][0], cQ[n][1]); wq.y = pk2(cQ[n][2], cQ[n][3]);
                    *(v2u*)(S_QR + (t0 + 16 * (cb0 + n) + fr) * C + h * 64 + 16 * rb + 4 * fq) = wq;
                }
                {
                    const f32x4 g4 = *(const LAS f32x4*)(lds + LA_GAM + (16 * rb + 4 * fq) * 4);
                    v4u wh; wh.x = pk2(g4[0] * accH[0][0], g4[1] * accH[0][1]); wh.y = pk2(g4[2] * accH[0][2], g4[3] * accH[0][3]); wh.z = pk2(g4[0] * accH[1][0], g4[1] * accH[1][1]); wh.w = pk2(g4[2] * accH[1][2], g4[3] * accH[1][3]);
                    *(v4u*)((bf16*)S_HP + ib + (size_t)(((rb * 2 + (wave & 1)) * 64 + ln) * 8)) = wh;
                }
            }
        }
#undef PROD2
        if (BOTH(3)) GRID_BAR();
    }
    if (IN(4)) {
        constexpr int MS = 144;
        const int rb = wave >> 1, cb0 = 2 * (wave & 1), fr = lane & 15, fq = lane >> 4, wodd = wave & 1;
        bf16* GCg = (bf16*)(ws + WS_GC); bf16* HCg = (bf16*)(ws + WS_HC);
        struct Ops { bf16x8 e0, e1; v4u hh, h2; };
#define PB_LOAD(q, Gb, Hb, ix) do { const size_t ib_ = (size_t)(ix) * 4096; \
            q.e0 = *(const bf16x8*)((Gb) + ib_ + (16 * rb + fr) * 64 + 8 * fq); q.e1 = *(const bf16x8*)((Gb) + ib_ + (16 * rb + fr) * 64 + 8 * fq + 32); \
            q.hh = *(const v4u*)((Hb) + ib_ + ((rb * 2 + wodd) * 64 + lane) * 8); } while (0)
#define PB_STEP(q, ix, par) do { LAS unsigned char* PT = lds + ((par) & 1) * 9216; \
            _Pragma("unroll") for (int n = 0; n < 2; ++n) { v2u w; w.x = pk2(Pst[n][0], Pst[n][1]); w.y = pk2(Pst[n][2], Pst[n][3]); \
                *(LAS v2u*)(PT + (16 * (cb0 + n) + fr) * MS + (16 * rb + 4 * fq) * 2) = w; } \
            asm volatile("s_waitcnt lgkmcnt(0)" ::: "memory"); __builtin_amdgcn_s_barrier(); asm volatile("" ::: "memory"); \
            *(v4u*)(PST + (size_t)(ix) * 4096 + (tid >> 3) * 64 + (tid & 7) * 8) = *(const LAS v4u*)(PT + (tid >> 3) * MS + (tid & 7) * 16); \
            f32x4 acc0 = (f32x4){bflo(q.hh.x), bfhi(q.hh.x), bflo(q.hh.y), bfhi(q.hh.y)}, acc1 = (f32x4){bflo(q.hh.z), bfhi(q.hh.z), bflo(q.hh.w), bfhi(q.hh.w)}; \
            { const bf16x8 b00 = *(const LAS bf16x8*)(PT + (16 * cb0 + fr) * MS + 16 * fq), b10 = *(const LAS bf16x8*)(PT + (16 * (cb0 + 1) + fr) * MS + 16 * fq); \
              const bf16x8 b01 = *(const LAS bf16x8*)(PT + (16 * cb0 + fr) * MS + 16 * fq + 64), b11 = *(const LAS bf16x8*)(PT + (16 * (cb0 + 1) + fr) * MS + 16 * fq + 64); \
              acc0 = __builtin_amdgcn_mfma_f32_16x16x32_bf16(q.e0, b00, acc0, 0, 0, 0); acc1 = __builtin_amdgcn_mfma_f32_16x16x32_bf16(q.e0, b10, acc1, 0, 0, 0); \
              acc0 = __builtin_amdgcn_mfma_f32_16x16x32_bf16(q.e1, b01, acc0, 0, 0, 0); acc1 = __builtin_amdgcn_mfma_f32_16x16x32_bf16(q.e1, b11, acc1, 0, 0, 0); } \
            Pst[0] = acc0; Pst[1] = acc1; } while (0)
        for (int tk = bx; tk < 512; tk += G) {
            const int chain = tk >> 4, g = tk & 15, b = chain >> 4, h = chain & 15;
            if (g == 15) continue;
            f32x4 Sst[4];
#pragma unroll
            for (int n = 0; n < 4; ++n)
#pragma unroll
                for (int rg = 0; rg < 4; ++rg) Sst[n][rg] = (!wodd && (16 * rb + 4 * fq + rg) == (16 * n + fr)) ? 1.0f : 0.0f;
            Ops qa[8], qb[8];
#define IT(cc) ((size_t)(b * 256 + 16 * g + (cc)) * 16 + h)
#define B1_LOAD(q, cc) do { PB_LOAD(q, S_E, (const bf16*)S_HP, IT(cc)); q.hh = *(const v4u*)((const bf16*)S_HP + IT(cc) * 4096 + ((rb * 2 + 0) * 64 + lane) * 8); q.h2 = *(const v4u*)((const bf16*)S_HP + IT(cc) * 4096 + ((rb * 2 + 1) * 64 + lane) * 8); } while (0)
#define B1_STEP(q, par) do { LAS unsigned char* PT = lds + ((par) & 1) * 18432; \
                _Pragma("unroll") for (int n = 0; n < 4; ++n) { v2u w; w.x = pk2(Sst[n][0], Sst[n][1]); w.y = pk2(Sst[n][2], Sst[n][3]); \
                    *(LAS v2u*)(PT + (16 * (4 * wodd + n) + fr) * MS + (16 * rb + 4 * fq) * 2) = w; } \
                asm volatile("s_waitcnt lgkmcnt(0)" ::: "memory"); __builtin_amdgcn_s_barrier(); asm volatile("" ::: "memory"); \
                f32x4 ac[4]; const unsigned hw[8] = {q.hh.x, q.hh.y, q.hh.z, q.hh.w, q.h2.x, q.h2.y, q.h2.z, q.h2.w}; \
                _Pragma("unroll") for (int n = 0; n < 4; ++n) ac[n] = wodd ? (f32x4){bflo(hw[2 * n]), bfhi(hw[2 * n]), bflo(hw[2 * n + 1]), bfhi(hw[2 * n + 1])} : (f32x4){0.f, 0.f, 0.f, 0.f}; \
                _Pragma("unroll") for (int n = 0; n < 4; ++n) { const LAS unsigned char* br = PT + (16 * (4 * wodd + n) + fr) * MS + 16 * fq; \
                    ac[n] = __builtin_amdgcn_mfma_f32_16x16x32_bf16(q.e0, *(const LAS bf16x8*)br, ac[n], 0, 0, 0); ac[n] = __builtin_amdgcn_mfma_f32_16x16x32_bf16(q.e1, *(const LAS bf16x8*)(br + 64), ac[n], 0, 0, 0); } \
                _Pragma("unroll") for (int n = 0; n < 4; ++n) Sst[n] = ac[n]; } while (0)
            __syncthreads();
#pragma unroll
            for (int j = 0; j < 8; ++j) B1_LOAD(qa[j], j);
#pragma unroll
            for (int j = 0; j < 4; ++j) B1_STEP(qa[j], j);
#pragma unroll
            for (int j = 0; j < 4; ++j) B1_LOAD(qb[j], 8 + j);
#pragma unroll
            for (int j = 4; j < 8; ++j) B1_STEP(qa[j], j);
#pragma unroll
            for (int j = 4; j < 8; ++j) B1_LOAD(qb[j], 8 + j);
#pragma unroll
            for (int j = 0; j < 8; ++j) B1_STEP(qb[j], j);
#undef B1_LOAD
#undef B1_STEP
            if (!wodd) {
#pragma unroll
                for (int n = 0; n < 4; ++n)
#pragma unroll
                    for (int rg = 0; rg < 4; ++rg) GCg[(size_t)tk * 4096 + (16 * rb + 4 * fq + rg) * 64 + 16 * n + fr] = (bf16)f2bf(Sst[n][rg]);
            } else {
#pragma unroll
                for (int p = 0; p < 2; ++p) { v4u w; w.x = pk2(Sst[2 * p][0], Sst[2 * p][1]); w.y = pk2(Sst[2 * p][2], Sst[2 * p][3]); w.z = pk2(Sst[2 * p + 1][0], Sst[2 * p + 1][1]); w.w = pk2(Sst[2 * p + 1][2], Sst[2 * p + 1][3]);
                    *(v4u*)(HCg + (size_t)tk * 4096 + ((rb * 2 + p) * 64 + lane) * 8) = w; }
            }
        }
        GRID_BAR();
        if (bx < 32) {
            const int b = bx >> 4, h = bx & 15;
            f32x4 Pst[2]; Pst[0] = (f32x4){0.f, 0.f, 0.f, 0.f}; Pst[1] = Pst[0];
            Ops qa[8], qb[8];
            __syncthreads();
#pragma unroll
            for (int j = 0; j < 8; ++j) PB_LOAD(qa[j], GCg, HCg, bx * 16 + j);
#pragma unroll
            for (int j = 0; j < 4; ++j) PB_STEP(qa[j], (size_t)(b * 256 + 16 * j) * 16 + h, j);
#pragma unroll
            for (int j = 0; j < 4; ++j) PB_LOAD(qb[j], GCg, HCg, bx * 16 + 8 + j);
#pragma unroll
            for (int j = 4; j < 8; ++j) PB_STEP(qa[j], (size_t)(b * 256 + 16 * j) * 16 + h, j);
#pragma unroll
            for (int j = 4; j < 8; ++j) PB_LOAD(qb[j], GCg, HCg, bx * 16 + (8 + j < 15 ? 8 + j : 14));
#pragma unroll
            for (int j = 0; j < 8; ++j) PB_STEP(qb[j], (size_t)(b * 256 + 16 * (8 + j)) * 16 + h, j);
        }
        {
        {
            constexpr int KS = 144, VS = 528;
            LAS unsigned char* Ks = lds; LAS unsigned char* VT = lds + 36864;
            const int fr = lane & 15, fq = lane >> 4, hg = wave >> 1, qh = wave & 1;
            LAS int* qslot = (LAS int*)(lds + TAB_OFF + 3072);
            int nxq = 0; if (tid == 0) nxq = (int)__hip_atomic_fetch_add(ctl + CW_ATTQ, 1u, RLX_AGENT);
            for (;;) {
                __syncthreads();
                if (tid == 0) *qslot = nxq;
                __syncthreads();
                const int un = *qslot; if (un >= 2 * 128 * 4) break;
                if (tid == 0) nxq = (int)__hip_atomic_fetch_add(ctl + CW_ATTQ, 1u, RLX_AGENT);
                const int g = un & 3, nb = (un >> 2) & 127, b = un >> 9;
                const size_t tq0 = (size_t)b * SEQ + (size_t)nb * 128;
                const int head = g * 4 + hg;
                bf16x8 qf[4][2];
#pragma unroll
                for (int qt = 0; qt < 4; ++qt) { const bf16* qp = Z + (tq0 + 64 * qh + 16 * qt + fr) * IN_COLS + ZC_Q + head * 64 + 8 * fq; qf[qt][0] = *(const bf16x8*)qp; qf[qt][1] = *(const bf16x8*)(qp + 32); }
                {
                    const int key = tid >> 1, hf = tid & 1; const bool ok = (nb > 0) || key >= 128;
                    const bf16* kp = Z + (ok ? tq0 + key - 128 : tq0) * IN_COLS + ZC_KA + g * 64 + hf * 32;
                    const int key2 = tid & 255, dh = tid >> 8; const bool ok2 = (nb > 0) || key2 >= 128;
                    const bf16* vp = Z + (ok2 ? tq0 + key2 - 128 : tq0) * IN_COLS + ZC_VA + g * 64 + dh * 32;
                    v4u kv[4], vv[4];
#pragma unroll
                    for (int c = 0; c < 4; ++c) kv[c] = *(const v4u*)(kp + c * 8);
#pragma unroll
                    for (int c = 0; c < 4; ++c) vv[c] = *(const v4u*)(vp + c * 8);
#pragma unroll
                    for (int c = 0; c < 4; ++c) *(LAS v4u*)(Ks + key * KS + hf * 64 + c * 16) = kv[c];
#pragma unroll
                    for (int c = 0; c < 4; ++c) {
                        LAS unsigned char* wp = VT + (32 * (c & 1) + 8 * dh + 4 * (c >> 1)) * VS + key2 * 2;
                        *(LAS bf16*)(wp + 0 * VS) = (bf16)(vv[c].x & 0xffffu); *(LAS bf16*)(wp + 1 * VS) = (bf16)(vv[c].x >> 16); *(LAS bf16*)(wp + 2 * VS) = (bf16)(vv[c].y & 0xffffu); *(LAS bf16*)(wp + 3 * VS) = (bf16)(vv[c].y >> 16);
                        *(LAS bf16*)(wp + 16 * VS) = (bf16)(vv[c].z & 0xffffu); *(LAS bf16*)(wp + 17 * VS) = (bf16)(vv[c].z >> 16); *(LAS bf16*)(wp + 18 * VS) = (bf16)(vv[c].w & 0xffffu); *(LAS bf16*)(wp + 19 * VS) = (bf16)(vv[c].w >> 16); }
                }
                __syncthreads();
                const float sink = args.in[I_SINK][head];
#pragma unroll
                for (int qt = 0; qt < 4; ++qt) {
                    const int ql0 = 64 * qh + 16 * qt, kt0 = 4 * qh + qt, ql = ql0 + fr;
                    const bf16x8 q0 = qf[qt][0], q1 = qf[qt][1];
                    f32x4 st[9];
#pragma unroll
                    for (int j = 0; j < 9; ++j) { const LAS unsigned char* ka = Ks + (16 * (kt0 + j) + fr) * KS + 16 * fq;
                        st[j] = __builtin_amdgcn_mfma_f32_16x16x32_bf16(*(const LAS bf16x8*)ka, q0, (f32x4){0.f, 0.f, 0.f, 0.f}, 0, 0, 0);
                        st[j] = __builtin_amdgcn_mfma_f32_16x16x32_bf16(*(const LAS bf16x8*)(ka + 64), q1, st[j], 0, 0, 0); }
#pragma unroll
                    for (int rg = 0; rg < 4; ++rg) { if (!(4 * fq + rg > fr)) st[0][rg] = -3.0e38f; if (!(4 * fq + rg <= fr)) st[8][rg] = -3.0e38f; }
                    if (nb == 0) {
#pragma unroll
                        for (int j = 0; j < 9; ++j)
#pragma unroll
                            for (int rg = 0; rg < 4; ++rg) { if (16 * (kt0 + j) + 4 * fq + rg < 128) st[j][rg] = -3.0e38f; }
                    }
                    float mx = -3.0e38f;
#pragma unroll
                    for (int j = 0; j < 9; ++j)
#pragma unroll
                        for (int rg = 0; rg < 4; ++rg) mx = fmaxf(mx, st[j][rg]);
                    mx = fmaxf(mx, __shfl_xor(mx, 16)); mx = fmaxf(mx, __shfl_xor(mx, 32)); mx = fmaxf(mx * 0.125f, sink);
                    const float cs = 0.125f * 1.44269504f, mc = mx * 1.44269504f;
                    float ls = 0.f;
#pragma unroll
                    for (int j = 0; j < 9; ++j)
#pragma unroll
                        for (int rg = 0; rg < 4; ++rg) { const float p = __builtin_amdgcn_exp2f(fmaf(st[j][rg], cs, -mc)); st[j][rg] = p; ls += p; }
                    ls += __shfl_xor(ls, 16); ls += __shfl_xor(ls, 32);
                    const float inv = 1.0f / (ls + __expf(sink - mx));
                    f32x4 ot[4];
#pragma unroll
                    for (int dt = 0; dt < 4; ++dt) ot[dt] = (f32x4){0.f, 0.f, 0.f, 0.f};
#pragma unroll
                    for (int i = 0; i < 5; ++i) {
                        v4u pw; pw.x = pk2(st[2 * i][0], st[2 * i][1]); pw.y = pk2(st[2 * i][2], st[2 * i][3]);
                        if (i < 4) { pw.z = pk2(st[2 * i + 1 < 9 ? 2 * i + 1 : 8][0], st[2 * i + 1 < 9 ? 2 * i + 1 : 8][1]); pw.w = pk2(st[2 * i + 1 < 9 ? 2 * i + 1 : 8][2], st[2 * i + 1 < 9 ? 2 * i + 1 : 8][3]); } else { pw.z = 0u; pw.w = 0u; }
                        const bf16x8 pb = __builtin_bit_cast(bf16x8, pw);
#pragma unroll
                        for (int dt = 0; dt < 4; ++dt) { const LAS unsigned char* vb = VT + (16 * dt + fr) * VS + (16 * (kt0 + 2 * i) + 4 * fq) * 2;
                            const v2u lo = *(const LAS v2u*)vb; v2u hi = (v2u){0u, 0u}; if (i < 4) hi = *(const LAS v2u*)(vb + 32);
                            const bf16x8 va = __builtin_bit_cast(bf16x8, (v4u){lo.x, lo.y, hi.x, hi.y});
                            ot[dt] = __builtin_amdgcn_mfma_f32_16x16x32_bf16(va, pb, ot[dt], 0, 0, 0); }
                    }
                    { v4u w; w.x = pk4_fp8(ot[0][0] * inv, ot[0][1] * inv, ot[0][2] * inv, ot[0][3] * inv); w.y = pk4_fp8(ot[1][0] * inv, ot[1][1] * inv, ot[1][2] * inv, ot[1][3] * inv);
                      w.z = pk4_fp8(ot[2][0] * inv, ot[2][1] * inv, ot[2][2] * inv, ot[2][3] * inv); w.w = pk4_fp8(ot[3][0] * inv, ot[3][1] * inv, ot[3][2] * inv, ot[3][3] * inv);
                      *(v4u*)((unsigned char*)YA + (tq0 + ql0 + fr) * C + head * 64 + 16 * fq) = w; }
                }
            }
        }
                }
        GRID_BAR();
        for (int tk = bx; tk < 512; tk += G) {
            const int chain = tk >> 4, g = tk & 15, b = chain >> 4, h = chain & 15;
            f32x4 Pst[2];
#pragma unroll
            for (int n = 0; n < 2; ++n) { const v2u w = *(const v2u*)(PST + IT(0) * 4096 + (16 * (cb0 + n) + fr) * 64 + 16 * rb + 4 * fq); Pst[n] = (f32x4){bflo(w.x), bfhi(w.x), bflo(w.y), bfhi(w.y)}; }
            Ops qa[8], qb[8];
            __syncthreads();
#pragma unroll
            for (int j = 0; j < 8; ++j) PB_LOAD(qa[j], S_E, (const bf16*)S_HP, IT(j));
#pragma unroll
            for (int j = 0; j < 4; ++j) PB_STEP(qa[j], IT(j), j);
#pragma unroll
            for (int j = 0; j < 4; ++j) PB_LOAD(qb[j], S_E, (const bf16*)S_HP, IT(8 + j));
#pragma unroll
            for (int j = 4; j < 8; ++j) PB_STEP(qa[j], IT(j), j);
#pragma unroll
            for (int j = 4; j < 8; ++j) PB_LOAD(qb[j], S_E, (const bf16*)S_HP, IT(8 + j));
#pragma unroll
            for (int j = 0; j < 8; ++j) PB_STEP(qb[j], IT(8 + j), j);
        }
#undef IT
#undef PB_LOAD
#undef PB_STEP
        if (BOTH(4)) GRID_BAR();
    }
    if (IN(5)) {
        const int fr = lane & 15, fq = lane >> 4;
        LAS float* ybuf = (LAS float*)(lds + wave * 4608);
        const int tl = lane >> 2, c16 = (lane & 3) * 16;
        int hcur = -1; f32x4 lg[4], lb[4];
        for (int task = gw; task < 8192 * 4; task += NGW) {
            const int item = task >> 2, rb = task & 3, h = item & 15, tb = item >> 4; const size_t t0 = (size_t)tb * 64, ib = (size_t)item * 4096;
            if (h != hcur) { hcur = h;
#pragma unroll
                for (int j = 0; j < 4; ++j) { lg[j] = *(const f32x4*)(args.in[I_LNG] + h * 64 + c16 + 4 * j); lb[j] = *(const f32x4*)(args.in[I_LNB] + h * 64 + c16 + 4 * j); } }
            bf16x8 aq[2]; aq[0] = *(const bf16x8*)(S_QR + (t0 + 16 * rb + fr) * C + h * 64 + 8 * fq); aq[1] = *(const bf16x8*)(S_QR + (t0 + 16 * rb + fr) * C + h * 64 + 8 * fq + 32);
            const size_t tt = t0 + 16 * rb + tl;
            const v4u vw0 = *(const v4u*)(S_V + tt * C + h * 64 + c16), vw1 = *(const v4u*)(S_V + tt * C + h * 64 + c16 + 8);
            const v4u gw0 = *(const v4u*)(S_G + tt * C + h * 64 + c16), gw1 = *(const v4u*)(S_G + tt * C + h * 64 + c16 + 8);
            const float bdv = BDg[tt * 16 + h];
            f32x4 acc[4];
#pragma unroll
            for (int cb = 0; cb < 4; ++cb) { const v2u wy = *(const v2u*)((const bf16*)S_YL + ib + ((rb * 4 + cb) * 64 + lane) * 4); acc[cb] = (f32x4){bflo(wy.x), bfhi(wy.x), bflo(wy.y), bfhi(wy.y)}; }
#pragma unroll
            for (int cb = 0; cb < 4; ++cb)
#pragma unroll
                for (int ks = 0; ks < 2; ++ks) { const bf16x8 bp = *(const bf16x8*)(PST + ib + (16 * cb + fr) * 64 + 8 * fq + 32 * ks);
                    acc[cb] = __builtin_amdgcn_mfma_f32_16x16x32_bf16(aq[ks], bp, acc[cb], 0, 0, 0); }
#pragma unroll
            for (int cb = 0; cb < 4; ++cb)
#pragma unroll
                for (int rg = 0; rg < 4; ++rg) ybuf[(4 * fq + rg) * 68 + 16 * cb + fr] = acc[cb][rg];
            LDS_WAIT(); asm volatile("" ::: "memory");
            f32x4 y[4];
#pragma unroll
            for (int j = 0; j < 4; ++j) y[j] = *(const LAS f32x4*)(ybuf + tl * 68 + c16 + 4 * j);
            LDS_WAIT(); asm volatile("" ::: "memory");
            float s = 0.f;
#pragma unroll
            for (int j = 0; j < 4; ++j) s += (y[j][0] + y[j][1]) + (y[j][2] + y[j][3]);
            s += dpp_xor1(s); s += dpp_xor2(s);
            const float mean = s * (1.f / 64.f); float q = 0.f;
#pragma unroll
            for (int j = 0; j < 4; ++j) { y[j] = y[j] - mean; q += (y[j][0] * y[j][0] + y[j][1] * y[j][1]) + (y[j][2] * y[j][2] + y[j][3] * y[j][3]); }
            q += dpp_xor1(q); q += dpp_xor2(q);
            const float rstd = 1.0f / sqrtf(q * (1.f / 64.f) + LNX_EPS);
            const unsigned vu[8] = {vw0.x, vw0.y, vw0.z, vw0.w, vw1.x, vw1.y, vw1.z, vw1.w}, gu[8] = {gw0.x, gw0.y, gw0.z, gw0.w, gw1.x, gw1.y, gw1.z, gw1.w};
            float of[16];
#pragma unroll
            for (int j = 0; j < 8; ++j) { const int a = j >> 1, e0 = (j & 1) * 2;
                of[2 * j] = (y[a][e0] * rstd * lg[a][e0] + lb[a][e0] + bdv * bflo(vu[j])) * bflo(gu[j]);
                of[2 * j + 1] = (y[a][e0 + 1] * rstd * lg[a][e0 + 1] + lb[a][e0 + 1] + bdv * bfhi(vu[j])) * bfhi(gu[j]); }
            *(v4u*)((unsigned char*)YR + tt * C + h * 64 + c16) = (v4u){pk4_fp8(of[0], of[1], of[2], of[3]), pk4_fp8(of[4], of[5], of[6], of[7]), pk4_fp8(of[8], of[9], of[10], of[11]), pk4_fp8(of[12], of[13], of[14], of[15])};
        }
        if (BOTH(5)) GRID_BAR();
    }
#undef FRAG

    if (IN(6)) {
        ProbUp<0> P; P.K = 1024; P.S.init(NT, D, G, bx); P.A = YR; P.Bt = WuprT; P.Z = Z; P.T1in = nullptr; P.O = T1;
        pg8::gemm_phase(lds, P);
        if (BOTH(6)) { VM_WAIT(); __syncthreads(); }
    }
    if (IN(7)) {
        ProbUp<1> P; P.K = 1024; P.S.init(NT, D, G, bx); P.A = YA; P.Bt = WupaT; P.Z = Z; P.T1in = T1; P.O = MG;
        pg8::gemm_phase(lds, P);
        if (BOTH(7)) GRID_BAR();
    }
    if (IN(8)) {
        ProbOut P; P.K = 2048; P.S.init(NT, D, G, bx); P.A = MG; P.Bt = WoutT; P.X = x; P.O = X1;
        pg8::gemm_phase(lds, P);
        if (BOTH(8)) GRID_BAR();
    }
    if (IN(9)) {
        constexpr int RS = 528, WBUF = 96 * RS;
        LAS unsigned* lcnt = (LAS unsigned*)(lds + 2 * WBUF + 1024);
        if (tid < 32) lcnt[tid] = 0u;
        const int fr = lane & 15, fq = lane >> 4;
        const float br0 = args.in[I_BR][fr], br1 = args.in[I_BR][16 + fr];
        for (int base = vcu * 8; base < NT / 16; base += NGW) {
            const int task = base + wave;
            const size_t tok0 = (size_t)task * 16;
            const bf16* xp = X1 + (tok0 + fr) * D + 8 * fq;
            v2u* hp8 = (v2u*)(H8 + (tok0 + fr) * D + 8 * fq);
            f32x4 acc0 = (f32x4){0.f, 0.f, 0.f, 0.f}, acc1 = acc0; float ssq = 0.f;
            v4u wst[6], xc[8];
            __syncthreads();
#pragma unroll
            for (int i = 0; i < 6; ++i) { const int p = tid + 512 * i; wst[i] = *(const v4u*)(WrS + (size_t)(p >> 5) * 2048 + (p & 31) * 8); }
#pragma unroll
            for (int j = 0; j < 8; ++j) xc[j] = *(const v4u*)(xp + 32 * j);
#pragma unroll
            for (int i = 0; i < 6; ++i) { const int p = tid + 512 * i; *(LAS v4u*)(lds + (p >> 5) * RS + (p & 31) * 16) = wst[i]; }
            asm volatile("s_waitcnt lgkmcnt(0)" ::: "memory"); __builtin_amdgcn_s_barrier(); asm volatile("" ::: "memory");
#pragma unroll
            for (int c = 0; c < 8; ++c) {
                const LAS unsigned char* WB = lds + (c & 1) * WBUF;
                v4u xn[8];
                if (c + 1 < 8) {
#pragma unroll
                    for (int i = 0; i < 6; ++i) { const int p = tid + 512 * i; wst[i] = *(const v4u*)(WrS + (size_t)(p >> 5) * 2048 + 256 * (c + 1) + (p & 31) * 8); }
#pragma unroll
                    for (int j = 0; j < 8; ++j) xn[j] = *(const v4u*)(xp + 32 * (8 * (c + 1) + j));
                }
                asm volatile("" ::: "memory");
                bf16x8 wf[2][6];
#pragma unroll
                for (int pp = 0; pp < 6; ++pp) wf[0][pp] = *(const LAS bf16x8*)(WB + fr * RS + (8 * fq) * 2 + ((pp >> 1) * 32 + (pp & 1) * 16) * RS);
#pragma unroll
                for (int j = 0; j < 8; ++j) {
                    const v4u xw = xc[j]; const bf16x8 xa8 = __builtin_bit_cast(bf16x8, xw);
                    if (j + 1 < 8) {
#pragma unroll
                        for (int pp = 0; pp < 6; ++pp) wf[(j + 1) & 1][pp] = *(const LAS bf16x8*)(WB + fr * RS + (32 * (j + 1) + 8 * fq) * 2 + ((pp >> 1) * 32 + (pp & 1) * 16) * RS);
                    }
                    asm volatile("" ::: "memory");
#pragma unroll
                    for (int part = 2; part >= 0; --part) {
                        acc0 = __builtin_amdgcn_mfma_f32_16x16x32_bf16(xa8, wf[j & 1][2 * part], acc0, 0, 0, 0);
                        acc1 = __builtin_amdgcn_mfma_f32_16x16x32_bf16(xa8, wf[j & 1][2 * part + 1], acc1, 0, 0, 0); }
                    const float xa[8] = {bflo(xw.x), bfhi(xw.x), bflo(xw.y), bfhi(xw.y), bflo(xw.z), bfhi(xw.z), bflo(xw.w), bfhi(xw.w)};
#pragma unroll
                    for (int s8 = 0; s8 < 8; ++s8) ssq += xa[s8] * xa[s8];
                    v2u hw; hw.x = pk4_fp8(xa[0], xa[1], xa[2], xa[3]); hw.y = pk4_fp8(xa[4], xa[5], xa[6], xa[7]); hp8[4 * (8 * c + j)] = hw;
                }
                if (c + 1 < 8) {
#pragma unroll
                    for (int i = 0; i < 6; ++i) { const int p = tid + 512 * i; *(LAS v4u*)(lds + ((c + 1) & 1) * WBUF + (p >> 5) * RS + (p & 31) * 16) = wst[i]; }
#pragma unroll
                    for (int j = 0; j < 8; ++j) xc[j] = xn[j];
                    asm volatile("s_waitcnt lgkmcnt(0)" ::: "memory"); __builtin_amdgcn_s_barrier(); asm volatile("" ::: "memory");
                }
            }
            ssq += __shfl_xor(ssq, 16); ssq += __shfl_xor(ssq, 32);
            const float rstd = 1.0f / sqrtf(ssq * (1.f / D) + NORM_EPS);
            if (fq == 0) rstd_tok[tok0 + fr] = rstd;
#pragma unroll
            for (int rg = 0; rg < 4; ++rg) {
                const float rs = __shfl(rstd, 4 * fq + rg);
                float v0 = acc0[rg] * rs + br0, v1 = acc1[rg] * rs + br1;
                int ti[4]; float tv[4];
#pragma unroll
                for (int r = 0; r < 4; ++r) {
                    float m = fmaxf(v0, v1); m = fmaxf(m, dpp_xor1(m)); m = fmaxf(m, dpp_xor2(m)); m = fmaxf(m, dpp_hmir(m)); m = fmaxf(m, dpp_rmir(m));
                    const int cand = (v0 == m) ? fr : ((v1 == m) ? 16 + fr : 99);
                    float cf = (float)cand; cf = fminf(cf, dpp_xor1(cf)); cf = fminf(cf, dpp_xor2(cf)); cf = fminf(cf, dpp_hmir(cf)); cf = fminf(cf, dpp_rmir(cf));
                    const int idx = (int)cf; ti[r] = idx; tv[r] = m;
                    if (idx == fr) v0 = -3.0e38f;
                    if (idx == 16 + fr) v1 = -3.0e38f;
                }
                const float e1 = __expf(tv[1] - tv[0]), e2 = __expf(tv[2] - tv[0]), e3 = __expf(tv[3] - tv[0]);
                const float inv = 1.0f / (1.0f + e1 + e2 + e3);
                const size_t tok = tok0 + 4 * fq + rg;
                if (fr == 0) { *(int4*)(topi + tok * 4) = make_int4(ti[0], ti[1], ti[2], ti[3]); *(f32x4*)(topg + tok * 4) = (f32x4){inv, e1 * inv, e2 * inv, e3 * inv}; }
                if (fr < 4) { const int ee = fr == 0 ? ti[0] : (fr == 1 ? ti[1] : (fr == 2 ? ti[2] : ti[3])); atomicAdd((unsigned*)&lcnt[ee & 31], 1u); }
            }
        }
        __syncthreads();
        if (tid < 32 && lcnt[tid] > 0u) __hip_atomic_fetch_add(cntw + tid, lcnt[tid], RLX_AGENT);
        if (BOTH(9)) GRID_BAR();
    }
    if (IN(10)) {
        LAS unsigned* lcnt = (LAS unsigned*)(lds);
        LAS unsigned* lbase = (LAS unsigned*)(lds + 256);
        LAS unsigned* lpos = (LAS unsigned*)(lds + 512);
        if (tid < 32) { lcnt[tid] = 0u; lpos[tid] = 0u; }
        __syncthreads();
        const int tpb = NT / G;
        const int tbeg = bx * tpb;
        for (int i = tid; i < tpb * 4; i += 512) { const int ee = topi[(size_t)tbeg * 4 + i]; atomicAdd((unsigned*)&lcnt[ee], 1u); }
        __syncthreads();
        if (tid < 32) {
            unsigned tbase = 0u;
            for (int j = 0; j < tid; ++j) tbase += (__hip_atomic_load(cntw + j, RLX_AGENT) + 255u) / 256u;
            const unsigned r0 = lcnt[tid] ? __hip_atomic_fetch_add(ctl + CW_CUR + tid, lcnt[tid], RLX_AGENT) : 0u;
            lbase[tid] = tbase * 256u + r0;
        }
        __syncthreads();
        for (int i = tid; i < tpb * 4; i += 512) { const int ee = topi[(size_t)tbeg * 4 + i];
            const unsigned p = atomicAdd((unsigned*)&lpos[ee], 1u); const unsigned slot = lbase[ee] + p;
            tokslot[slot] = tbeg + (i >> 2); slotof[(size_t)tbeg * 4 + i] = (int)slot; rss[slot] = rstd_tok[tbeg + (i >> 2)]; }
        if (BOTH(10)) GRID_BAR();
    }
    if (IN(11) || IN(12)) {
        __syncthreads();
        if (tid == 0) { int t = 0;
            for (int e = 0; e < NE; ++e) { const int n = (int)((__hip_atomic_load(cntw + e, RLX_AGENT) + 255u) / 256u); for (int j = 0; j < n && t < MAX_TILES; ++j) TAB[t++] = e; }
            TAB[MAX_TILES] = t; }
        __syncthreads();
    }
    if (IN(11)) {
        ProbMoe1 P; P.K = 2048; P.S.tile_e = TAB; P.S.ntiles = __builtin_amdgcn_readfirstlane(TAB[MAX_TILES]); P.S.G = G; P.S.c = bx;
        P.H2 = H8; P.W1t = W1T; P.b1 = args.in[I_B1]; P.tokslot = tokslot; P.ACT = ACT; P.rss = rss;
        pg8::gemm_phase(lds, P);
        if (BOTH(11)) GRID_BAR();
    }
    if (IN(12)) {
        ProbMoe2 P; P.K = 2048; P.S.tile_e = TAB; P.S.ntiles = __builtin_amdgcn_readfirstlane(TAB[MAX_TILES]); P.S.G = G; P.S.c = bx;
        P.ACT = ACT; P.W2t = W2T; P.b2 = args.in[I_B2]; P.Y = Yb;
        pg8::gemm_phase(lds, P);
        if (BOTH(12)) GRID_BAR();
    }
    if (IN(13)) {
        const float* gf = args.in[I_NFG];
        for (int tok = gw; tok < NT; tok += NGW) {
            const v2u* xr = (const v2u*)(X1 + (size_t)tok * D) + lane;
            const int4 sl = *(const int4*)(slotof + (size_t)tok * 4); const f32x4 gt = *(const f32x4*)(topg + (size_t)tok * 4);
            const unsigned* y0 = (const unsigned*)(Yb + (size_t)sl.x * D) + lane; const unsigned* y1 = (const unsigned*)(Yb + (size_t)sl.y * D) + lane;
            const unsigned* y2 = (const unsigned*)(Yb + (size_t)sl.z * D) + lane; const unsigned* y3 = (const unsigned*)(Yb + (size_t)sl.w * D) + lane;
            f32x4 v[8]; float s = 0.f;
#pragma unroll
            for (int j = 0; j < 8; ++j) { { const v2u xw = __builtin_nontemporal_load(xr + 64 * j); v[j] = (f32x4){bflo(xw.x), bfhi(xw.x), bflo(xw.y), bfhi(xw.y)}; } const unsigned a = __builtin_nontemporal_load(y0 + 64 * j), b = __builtin_nontemporal_load(y1 + 64 * j), c = __builtin_nontemporal_load(y2 + 64 * j), d = __builtin_nontemporal_load(y3 + 64 * j);
                const f32x2 a0 = __builtin_amdgcn_cvt_pk_f32_fp8(a, false), a1 = __builtin_amdgcn_cvt_pk_f32_fp8(a, true), b0 = __builtin_amdgcn_cvt_pk_f32_fp8(b, false), b1 = __builtin_amdgcn_cvt_pk_f32_fp8(b, true);
                const f32x2 c0 = __builtin_amdgcn_cvt_pk_f32_fp8(c, false), c1 = __builtin_amdgcn_cvt_pk_f32_fp8(c, true), d0 = __builtin_amdgcn_cvt_pk_f32_fp8(d, false), d1 = __builtin_amdgcn_cvt_pk_f32_fp8(d, true);
                v[j].x += gt.x * a0[0] + gt.y * b0[0] + gt.z * c0[0] + gt.w * d0[0];
                v[j].y += gt.x * a0[1] + gt.y * b0[1] + gt.z * c0[1] + gt.w * d0[1];
                v[j].z += gt.x * a1[0] + gt.y * b1[0] + gt.z * c1[0] + gt.w * d1[0];
                v[j].w += gt.x * a1[1] + gt.y * b1[1] + gt.z * c1[1] + gt.w * d1[1];
                s += (v[j].x * v[j].x + v[j].y * v[j].y) + (v[j].z * v[j].z + v[j].w * v[j].w); }
            const float rstd = 1.0f / sqrtf(wave_sum(s) * (1.f / D) + NORM_EPS);
            f32x4* op = (f32x4*)(args.out + (size_t)tok * D) + lane; const f32x4* gr = (const f32x4*)gf + lane;
#pragma unroll
            for (int j = 0; j < 8; ++j) { const f32x4 gg = gr[64 * j]; __builtin_nontemporal_store((f32x4){v[j].x * rstd * gg.x, v[j].y * rstd * gg.y, v[j].z * rstd * gg.z, v[j].w * rstd * gg.w}, op + 64 * j); }
        }
    }
#undef IN
#undef BOTH
}

extern "C" void kernel_launch(void* const* d_in, const int* in_sizes, int n_in, void* d_out, int out_size, void* d_ws, size_t ws_size, hipStream_t stream) {
    static int grid = 0;
    if (grid == 0) {
        if (n_in != 27 || out_size != NT * D || ws_size < WS_END) { fprintf(stderr, "kernel_launch: unexpected shapes (n_in %d out %d ws %zu)\n", n_in, out_size, ws_size); grid = -1; return; }
        int dev = 0, cus = 0;
        if (hipGetDevice(&dev) != hipSuccess || hipDeviceGetAttribute(&cus, hipDeviceAttributeMultiprocessorCount, dev) != hipSuccess) { grid = -1; return; }
        if (hipFuncSetAttribute((const void*)fwd, hipFuncAttributeMaxDynamicSharedMemorySize, LDS_BYTES) != hipSuccess) { fprintf(stderr, "kernel_launch: hipFuncSetAttribute failed\n"); grid = -1; return; }
        int per_cu = 0;
        if (hipOccupancyMaxActiveBlocksPerMultiprocessor(&per_cu, (const void*)fwd, 512, LDS_BYTES) != hipSuccess || per_cu < 1) fprintf(stderr, "kernel_launch: occupancy query reports %d\n", per_cu);
        (void)hipGetLastError();
        grid = cus;
    }
    if (grid < 0) return;
    (void)hipMemsetAsync((char*)d_ws + WS_CTL, 0, CTL_ZERO_BYTES, stream);
    Args a{};
    for (int i = 0; i < 27; ++i) a.in[i] = (const float*)d_in[i];
    a.out = (float*)d_out; a.ws = (unsigned char*)d_ws;
#if MK_N_LAUNCHES == 1
#if defined(PROBE_LO)
    a.ph_lo = 0; a.ph_hi = PROBE_HI; a.li = 0;
    hipLaunchKernelGGL(fwd, dim3(grid), dim3(512), LDS_BYTES, stream, a);
    a.ph_lo = PROBE_LO; a.ph_hi = NPHASE; a.li = 1;
    hipLaunchKernelGGL(fwd, dim3(grid), dim3(512), LDS_BYTES, stream, a);
#else
    a.ph_lo = 0; a.ph_hi = NPHASE; a.li = 0;
    hipLaunchKernelGGL(fwd, dim3(grid), dim3(512), LDS_BYTES, stream, a);
#endif
#else
    for (int p = 0; p < NPHASE; ++p) { a.ph_lo = p; a.ph_hi = p + 1; a.li = p; hipLaunchKernelGGL(fwd, dim3(grid), dim3(512), LDS_BYTES, stream, a); }
#endif
}
```

```cpp
#include <hip/hip_runtime.h>
#include <cstdio>
#include <cstdint>

#ifndef MK_N_LAUNCHES
#define MK_N_LAUNCHES 1
#endif

#define LAS __attribute__((address_space(3)))
typedef unsigned short bf16;
typedef unsigned v4u __attribute__((ext_vector_type(4)));
typedef unsigned v2u __attribute__((ext_vector_type(2)));
typedef float f32x4 __attribute__((ext_vector_type(4)));
typedef float f32x2 __attribute__((ext_vector_type(2)));
typedef short bf16x8 __attribute__((ext_vector_type(8)));
typedef int v4i __attribute__((ext_vector_type(4)));
typedef int v8i __attribute__((ext_vector_type(8)));

constexpr int NT = 32768, SEQ = 16384, D = 2048, C = 1024, NH = 16, HD = 64;
constexpr int IN_COLS = 8960;
constexpr int ZC_R = 0, ZC_K = 1024, ZC_V = 2048, ZC_LORA = 3072, ZC_Q = 3328, ZC_KA = 4352, ZC_VA = 4608, ZC_GR = 4864, ZC_GA = 6912;
constexpr int NE = 32, TOPK = 4, DFF = 2048;
constexpr int MAX_TILES = NT * TOPK / 256 + NE;
constexpr int NSLOT = MAX_TILES * 256;
constexpr float NORM_EPS = 1e-5f, LNX_EPS = 64e-5f;

constexpr size_t MiB = 1u << 20;
constexpr size_t WS_CTL = 0, CTL_ZERO_BYTES = 2 * MiB;
constexpr size_t WS_TOPI = 2 * MiB;
constexpr size_t WS_TOPG = 3 * MiB;
constexpr size_t WS_SLOT = 4 * MiB;
constexpr size_t WS_WIN_T = 8 * MiB;
constexpr size_t WS_WUPR_T = 44 * MiB;
constexpr size_t WS_WUPA_T = 48 * MiB;
constexpr size_t WS_WOUT_T = 52 * MiB;
constexpr size_t WS_WD_T = 60 * MiB, WS_WI_T = WS_WD_T + 131072, WS_WG_T = WS_WI_T + 131072;
constexpr size_t WS_WRT = 61 * MiB;
constexpr size_t WS_W1_T = 64 * MiB;
constexpr size_t WS_W2_T = 576 * MiB;
constexpr size_t WS_H = 832 * MiB;
constexpr size_t WS_Z = 960 * MiB;
constexpr size_t WS_SCAN = 1520 * MiB;
constexpr size_t WS_ACT = WS_SCAN;
constexpr size_t WS_YR = 2416 * MiB;
constexpr size_t WS_YA = 2480 * MiB;
constexpr size_t WS_T1 = 2544 * MiB;
constexpr size_t WS_MG = 2672 * MiB;
constexpr size_t WS_Y = 2800 * MiB;
constexpr size_t WS_PST = 3344 * MiB;
constexpr size_t WS_GAM = 3408 * MiB;
constexpr size_t WS_BD = 3410 * MiB;
constexpr size_t WS_X1 = 3412 * MiB;
constexpr size_t WS_GC = 3668 * MiB, WS_HC = 3672 * MiB;
constexpr size_t WS_H1F = 3676 * MiB;
constexpr size_t WS_WING = 3740 * MiB;
constexpr size_t WS_END = 3748 * MiB;
constexpr size_t SC_R = 0, SC_KF = 64 * MiB, SC_V = 128 * MiB, SC_AN = 192 * MiB, SC_BN = 256 * MiB, SC_G = 320 * MiB;
constexpr size_t SC_LW = 384 * MiB;
constexpr size_t SC_QR = 512 * MiB;
constexpr size_t SC_YL = 576 * MiB;
constexpr size_t SC_E = 704 * MiB;
constexpr size_t SC_HP = 768 * MiB;
constexpr int CW_BAR = 1024;
constexpr int CW_CNT = 8192;
constexpr int CW_CUR = 8192 + 64;
constexpr int CW_ATTQ = 8192 + 192;
constexpr int CW_TOKSLOT = 16384;
constexpr int CW_RSS = CW_TOKSLOT + NSLOT;
static_assert((CW_RSS + NSLOT) * 4 <= (int)CTL_ZERO_BYTES, "ctl");

constexpr int RING_BYTES = 131072;
constexpr int TAB_OFF = RING_BYTES;
constexpr int MISC_OFF = RING_BYTES + 4096;
constexpr int LDS_BYTES = 147456;

#define RLX_AGENT __ATOMIC_RELAXED, __HIP_MEMORY_SCOPE_AGENT
#define LDS_WAIT() asm volatile("s_waitcnt lgkmcnt(0)" ::: "memory")
#define VM_WAIT() asm volatile("s_waitcnt vmcnt(0)" ::: "memory")
__device__ __forceinline__ unsigned f2bf(float f) { return (unsigned)__builtin_bit_cast(unsigned short, (__bf16)f); }
typedef __bf16 bf2_t __attribute__((ext_vector_type(2)));
typedef short s16x4 __attribute__((ext_vector_type(4)));
__device__ __forceinline__ unsigned pk2(float lo, float hi) { bf2_t v; v[0] = (__bf16)lo; v[1] = (__bf16)hi; return __builtin_bit_cast(unsigned, v); }
__device__ __forceinline__ unsigned pk4_fp8(float a, float b, float c, float d) { unsigned w = 0u; w = __builtin_amdgcn_cvt_pk_fp8_f32(a, b, w, false); w = __builtin_amdgcn_cvt_pk_fp8_f32(c, d, w, true); return w; }
__device__ __forceinline__ float bflo(unsigned w) { return __builtin_bit_cast(float, w << 16); }
__device__ __forceinline__ float bfhi(unsigned w) { return __builtin_bit_cast(float, w & 0xffff0000u); }
__device__ __forceinline__ float bf1(bf16 b) { return __builtin_bit_cast(float, (unsigned)b << 16); }
__device__ __forceinline__ float sigmoidf_(float x) { return __builtin_amdgcn_rcpf(1.0f + __expf(-x)); }
__device__ __forceinline__ float wave_sum(float v) {
#pragma unroll
    for (int o = 1; o < 64; o <<= 1) v += __shfl_xor(v, o);
    return v;
}

#define XB_TMO      128
#define XB_XCNT(j)  (256  + 64 * (j))
#define XB_XSUB(j)  (1280 + 64 * (j))
#define XB_XGEN(j)  (2304 + 64 * (j))
#define XB_TOP      3328
#define XB_TOPGEN   3392
#define XCD_BAR_WORDS 3456
#define XB_SPIN_CAP (1u << 22)
__device__ __forceinline__ unsigned xb_ld(unsigned* p)              { return __hip_atomic_load(p, __ATOMIC_RELAXED, __HIP_MEMORY_SCOPE_AGENT); }
__device__ __forceinline__ unsigned xb_add(unsigned* p, unsigned v) { return __hip_atomic_fetch_add(p, v, __ATOMIC_RELAXED, __HIP_MEMORY_SCOPE_AGENT); }
__device__ __forceinline__ unsigned xb_xcc_id() { return (unsigned)__builtin_amdgcn_s_getreg((3 << 11) | 20) & 0xFu; }
#define XB_SPIN(cond, bar) do { unsigned _sp = 0; while (cond) { __builtin_amdgcn_s_sleep(1); \
    if ((++_sp & 255u) == 0u) { if (xb_ld(&(bar)[XB_TMO])) break; if (_sp > XB_SPIN_CAP) { atomicAdd(&(bar)[XB_TMO], 1u); break; } } } } while (0)
struct XcdBarrier { unsigned* bar; unsigned x; volatile LAS unsigned* st; };
__device__ __forceinline__ XcdBarrier xcd_barrier_post(unsigned* bar, volatile LAS unsigned* st) {
    XcdBarrier b; b.bar = bar; b.x = xb_xcc_id(); b.st = st;
    if (threadIdx.x == 0) (void)xb_add(&bar[XB_XCNT(b.x)], 1u);
    return b;
}
__device__ __forceinline__ void xcd_barrier_complete(unsigned* bar, unsigned x, unsigned& nloc, unsigned& nx) {
    const unsigned G = gridDim.x * gridDim.y * gridDim.z;
    unsigned sum, cnt, mine, sp = 0u;
    for (;;) {
        sum = 0u; cnt = 0u; mine = 0u;
#pragma unroll
        for (unsigned j = 0; j < 16; ++j) { const unsigned c = xb_ld(&bar[XB_XCNT(j)]); sum += c; cnt += (c > 0u) ? 1u : 0u; mine = (j == x) ? c : mine; }
        if (sum == G) break;
        __builtin_amdgcn_s_sleep(1);
        if ((++sp & 255u) == 0u) { if (xb_ld(&bar[XB_TMO])) break; if (sp > XB_SPIN_CAP) { atomicAdd(&bar[XB_TMO], 1u); break; } }
    }
    nloc = mine > 0u ? mine : 1u; nx = cnt > 0u ? cnt : 1u;
}
__device__ __forceinline__ void xcd_barrier(const XcdBarrier& b) {
    asm volatile("s_waitcnt vmcnt(0)" ::: "memory");
    __syncthreads();
    if (threadIdx.x == 0) {
        unsigned* bar = b.bar;
        __builtin_amdgcn_s_waitcnt(0);
        unsigned nloc = b.st[0], nx = b.st[1];
        if (nloc == 0u) { xcd_barrier_complete(bar, b.x, nloc, nx); b.st[0] = nloc; b.st[1] = nx; }
        const unsigned old = xb_add(&bar[XB_XSUB(b.x)], 1u);
        const unsigned gen = old / nloc;
        if (old + 1u == (gen + 1u) * nloc) {
            __builtin_amdgcn_fence(__ATOMIC_RELEASE, "agent");
            asm volatile("s_waitcnt vmcnt(0)" ::: "memory");
            const unsigned og = xb_add(&bar[XB_TOP], 1u);
            const unsigned tg = og / nx;
            if (og + 1u == (tg + 1u) * nx) xb_add(&bar[XB_TOPGEN], 1u);
            else XB_SPIN(xb_ld(&bar[XB_TOPGEN]) == tg, bar);
            __builtin_amdgcn_fence(__ATOMIC_ACQUIRE, "agent");
            xb_add(&bar[XB_XGEN(b.x)], 1u);
            asm volatile("s_waitcnt vmcnt(0)" ::: "memory");
        } else {
            XB_SPIN(xb_ld(&bar[XB_XGEN(b.x)]) == gen, bar);
            __builtin_amdgcn_fence(__ATOMIC_ACQUIRE, "agent");
            asm volatile("s_waitcnt vmcnt(0)" ::: "memory");
        }
    }
    __syncthreads();
}

namespace pg8 {
constexpr int BM = 256, BK = 64, HALF = 128, HTB = HALF * BK * 2, STAGE_BYTES = 8 * HTB, NXCD = 8, WGM = 8;
__device__ __forceinline__ int lds_byte(int r, int c) { const int st = (r >> 4) * 2 + (c >> 5), rr = r & 15, cc = c & 31, ob = rr * 64 + cc * 2; return st * 1024 + (ob ^ (((ob >> 9) & 1) << 5)); }
__device__ __forceinline__ void stage_rc(int b, int& R, int& Cc) { const int st = b / 1024, sb = b % 1024, swz = sb ^ (((sb >> 9) & 1) << 5); R = (st >> 1) * 16 + swz / 64; Cc = (st & 1) * 32 + (swz % 64) / 2; }
__device__ __forceinline__ int perm32(int rho) { const int n = rho >> 4, i = rho & 15; return 8 * (i >> 2) + 4 * n + (i & 3); }
struct Unit { int pm, pn, e; };
__device__ __forceinline__ int xcd_remap(int wgid, int nwg) { const int q = nwg / NXCD, r = nwg % NXCD, xcd = wgid % NXCD, off = wgid / NXCD; return (xcd < r ? xcd * (q + 1) : r * (q + 1) + (xcd - r) * q) + off; }
struct DenseOrder {
    int nM, nN, nwg, G, c;
    __device__ __forceinline__ void init(int M, int N, int G_, int c_) { nM = M / BM; nN = N / BM; nwg = nM * nN; G = G_; c = c_; }
    __device__ __forceinline__ bool next(int i, Unit& u) const {
        const long L = (long)i * G + c; if (L >= nwg) return false;
        const int wgid = xcd_remap((int)L, nwg);
        const int nig = WGM * nN, gid = wgid / nig, fm = gid * WGM, gsz = (nM - fm) < WGM ? (nM - fm) : WGM;
        u.pm = fm + ((wgid % nig) % gsz); u.pn = (wgid % nig) / gsz; u.e = 0; return true;
    }
};
struct BalancedOrder {
    int nM, nN, nwg, G, c, rem, base, extra;
    __device__ __forceinline__ void init(int M, int N, int G_, int c_, int rem_, int extra_) { nM = M / BM; nN = N / BM; nwg = nM * nN; G = G_; c = c_; rem = rem_; extra = extra_;
        const int t = nwg - extra_ * (G_ - rem_); base = (t >= 0 && t % G_ == 0) ? t / G_ : -1; }
    __device__ __forceinline__ bool next(int i, Unit& u) const {
        long L;
        if (base < 0) { L = (long)i * G + c; if (L >= nwg) return false; }
        else if (i < base) L = (long)i * G + c;
        else if (c >= rem && i < base + extra) L = (long)base * G + (long)(i - base) * (G - rem) + (c - rem);
        else return false;
        const int wgid = xcd_remap((int)L, nwg);
        const int nig = WGM * nN, gid = wgid / nig, fm = gid * WGM, gsz = (nM - fm) < WGM ? (nM - fm) : WGM;
        u.pm = fm + ((wgid % nig) % gsz); u.pn = (wgid % nig) / gsz; u.e = 0; return true;
    }
};
template <int NPN> struct MoeOrder {
    const LAS int* tile_e; int ntiles, G, c;
    __device__ __forceinline__ bool next(int i, Unit& u) const {
        const long L = (long)i * G + c; const int nwg = ntiles * NPN; if (L >= nwg) return false;
        const int wgid = xcd_remap((int)L, nwg);
        { const int nig = WGM * NPN, gid = wgid / nig, fm = gid * WGM, gsz = (ntiles - fm) < WGM ? (ntiles - fm) : WGM;
          u.pm = fm + ((wgid % nig) % gsz); u.pn = (wgid % nig) / gsz; }
        u.e = __builtin_amdgcn_readfirstlane(tile_e[u.pm]); return true;
    }
};
typedef f32x4 Acc[2][2][4][2];

template <class Prob>
__device__ __forceinline__ void gemm_phase(LAS unsigned char* lds, const Prob& P) {
    int tid = threadIdx.x; asm volatile("" : "+v"(tid));
    const int wid = __builtin_amdgcn_readfirstlane(tid >> 6), lane = tid & 63, wr = wid >> 2, wc = wid & 3, fr = lane & 15, fq = lane >> 4;
    const int K = P.K, nt = Prob::FP8 ? K / 128 : K / BK;
    constexpr int EB = Prob::FP8 ? 1 : 2;
    unsigned voffB[2], voffA[2]; int Rst[2]; unsigned cst[2];
#pragma unroll
    for (int i = 0; i < 2; ++i) { int R, Cc; stage_rc(tid * 16 + i * 8192, R, Cc); const int p_ = perm32(R & 31); const int Rb = Prob::PERM64 ? (64 * (R >> 5) + 16 * (p_ >> 3) + (p_ & 7)) : (Prob::PERM ? ((R & ~31) + p_) : R);
        Rst[i] = R; cst[i] = (unsigned)Cc * 2u; voffA[i] = (unsigned)(R * K * EB + Cc * 2); voffB[i] = (unsigned)(Rb * K * EB + Cc * 2); }
    const size_t kstep = (size_t)(BK * 2);
    const unsigned ldsw = (unsigned)wid * 1024u;
    const int aoff = lds_byte(wr * 64 + fr, fq * 8), boff = lds_byte(wc * 32 + fr, fq * 8);
#define PG8_SA(b, h) (((b) * 2 + (h)) * HTB)
#define PG8_SB(b, h) ((4 + (b) * 2 + (h)) * HTB)
#define PG8_STAGE(bufoff, gbase, v0, v1) do { \
        __builtin_amdgcn_global_load_lds((const unsigned*)((const char*)(gbase) + (v0)), (LAS unsigned*)(lds + (bufoff) + ldsw), 16, 0, 0); \
        __builtin_amdgcn_global_load_lds((const unsigned*)((const char*)(gbase) + (v1)), (LAS unsigned*)(lds + (bufoff) + ldsw + 8192), 16, 0, 0); } while (0)
#define PG8_LD8(dst, off) do { const v4i lo_ = *(const LAS v4i*)(lds + (off)); const v4i hi_ = *(const LAS v4i*)(lds + (off) + 1024); dst = __builtin_shufflevector(lo_, hi_, 0, 1, 2, 3, 4, 5, 6, 7); } while (0)
#define PG8_LDA(dst, b, h) do { _Pragma("unroll") for (int m = 0; m < 4; ++m) PG8_LD8(dst[m], PG8_SA(b, h) + aoff + m * 2048); } while (0)
#define PG8_LDB(dst, b, h) do { _Pragma("unroll") for (int n = 0; n < 2; ++n) PG8_LD8(dst[n], PG8_SB(b, h) + boff + n * 2048); } while (0)
#define PG8_MMA(ai, bj, At, Bt) do { __builtin_amdgcn_s_setprio(1); if constexpr (Prob::FP8) asm volatile("s_nop 1"); _Pragma("unroll") for (int m = 0; m < 4; ++m) _Pragma("unroll") for (int n = 0; n < 2; ++n) { \
        if constexpr (Prob::FP8) asm volatile("v_mfma_scale_f32_16x16x128_f8f6f4 %0, %1, %2, %0, %3, %4 op_sel_hi:[0,0,0]" : "+v"(acc[ai][bj][m][n]) : "v"(Bt[n]), "v"(At[m]), "v"(sc_w), "v"(sc_a));   \
        else { acc[ai][bj][m][n] = __builtin_amdgcn_mfma_f32_16x16x32_bf16((bf16x8)__builtin_shufflevector(Bt[n], Bt[n], 0, 1, 2, 3), (bf16x8)__builtin_shufflevector(At[m], At[m], 0, 1, 2, 3), acc[ai][bj][m][n], 0, 0, 0); \
               acc[ai][bj][m][n] = __builtin_amdgcn_mfma_f32_16x16x32_bf16((bf16x8)__builtin_shufflevector(Bt[n], Bt[n], 4, 5, 6, 7), (bf16x8)__builtin_shufflevector(At[m], At[m], 4, 5, 6, 7), acc[ai][bj][m][n], 0, 0, 0); } } \
        __builtin_amdgcn_s_setprio(0); } while (0)
#define PG8_WAIT_V(n) asm volatile("s_waitcnt vmcnt(" #n ")" ::: "memory")
#define PG8_WAIT_L(n) asm volatile("s_waitcnt lgkmcnt(" #n ")" ::: "memory")
#define PG8_BAR __builtin_amdgcn_s_barrier()
#define PG8_SCHED __builtin_amdgcn_sched_barrier(0)
    Unit cur, nxt; int ui = 0;
    if (!P.next(0, cur)) return;
    Acc acc;
#pragma unroll
    for (int a = 0; a < 2; ++a)
#pragma unroll
        for (int b = 0; b < 2; ++b)
#pragma unroll
            for (int m = 0; m < 4; ++m)
#pragma unroll
                for (int n = 0; n < 2; ++n) acc[a][b][m][n] = (f32x4){0.f, 0.f, 0.f, 0.f};
    v8i At[4], B0[2], B1[2];
    int sc_w = 121, sc_a = 127;
    if constexpr (Prob::FP8) asm volatile("" : "+v"(sc_w), "+v"(sc_a));
    const char *cA0 = P.a_base(cur, 0), *cA1 = P.a_base(cur, 1), *cB0 = P.b_base(cur, 0), *cB1 = P.b_base(cur, 1);
    unsigned c00 = voffA[0], c01 = voffA[1], c10 = voffA[0], c11 = voffA[1];
    unsigned n00 = c00, n01 = c01, n10 = c10, n11 = c11;
    if constexpr (Prob::GATHER) { c00 = P.gather(cur, 0, Rst[0]) + cst[0]; c01 = P.gather(cur, 0, Rst[1]) + cst[1]; c10 = P.gather(cur, 1, Rst[0]) + cst[0]; c11 = P.gather(cur, 1, Rst[1]) + cst[1]; }
    PG8_STAGE(PG8_SB(0, 0), cB0, voffB[0], voffB[1]); PG8_STAGE(PG8_SB(0, 1), cB1, voffB[0], voffB[1]); PG8_STAGE(PG8_SA(0, 0), cA0, c00, c01); PG8_STAGE(PG8_SA(0, 1), cA1, c10, c11);
    if (wr == 1) PG8_BAR;
    PG8_WAIT_V(2); PG8_BAR;
    PG8_STAGE(PG8_SB(1, 0), cB0 + kstep, voffB[0], voffB[1]); PG8_STAGE(PG8_SB(1, 1), cB1 + kstep, voffB[0], voffB[1]);
    PG8_WAIT_V(4); PG8_BAR;
    for (;;) {
        const bool has_next = P.next(ui + 1, nxt);
        const char *nA0 = cA0, *nA1 = cA1, *nB0 = cB0, *nB1 = cB1;
        if (has_next) { nA0 = P.a_base(nxt, 0); nA1 = P.a_base(nxt, 1); nB0 = P.b_base(nxt, 0); nB1 = P.b_base(nxt, 1); }
        if constexpr (Prob::GATHER) {
            if (has_next) { n00 = P.gather(nxt, 0, Rst[0]) + cst[0]; n01 = P.gather(nxt, 0, Rst[1]) + cst[1]; n10 = P.gather(nxt, 1, Rst[0]) + cst[0]; n11 = P.gather(nxt, 1, Rst[1]) + cst[1]; }
            else { n00 = c00; n01 = c01; n10 = c10; n11 = c11; }
        }
        for (int t = 0; t < nt; t += 2) {
            const bool last = (t == nt - 2);
            const char* a1h1 = cA1 + (size_t)(t + 1) * kstep;
            const char* a2h0 = last ? nA0 : cA0 + (size_t)(t + 2) * kstep; const char* a2h1 = last ? nA1 : cA1 + (size_t)(t + 2) * kstep;
            const char* b2h0 = last ? nB0 : cB0 + (size_t)(t + 2) * kstep; const char* b2h1 = last ? nB1 : cB1 + (size_t)(t + 2) * kstep;
            const char* b3h0 = b2h0 + kstep; const char* b3h1 = b2h1 + kstep;
            unsigned v00 = c00, v01 = c01, v10 = c10, v11 = c11;
            if constexpr (Prob::GATHER) { if (last) { v00 = n00; v01 = n01; v10 = n10; v11 = n11; }
                asm volatile("" : "+v"(v00), "+v"(v01), "+v"(v10), "+v"(v11)); }
            unsigned w10 = c10, w11 = c11; if constexpr (Prob::GATHER) asm volatile("" : "+v"(w10), "+v"(w11));
            const char* a1h0 = cA0 + (size_t)(t + 1) * kstep;
            unsigned w00 = c00, w01 = c01; if constexpr (Prob::GATHER) asm volatile("" : "+v"(w00), "+v"(w01));
            PG8_LDB(B0, 0, 0); PG8_LDB(B1, 0, 1); PG8_SCHED; PG8_LDA(At, 0, 0); PG8_STAGE(PG8_SA(1, 0), a1h0, w00, w01); PG8_STAGE(PG8_SA(1, 1), a1h1, w10, w11);
            PG8_WAIT_V(8); PG8_WAIT_L(0); PG8_BAR; PG8_MMA(0, 0, At, B0); PG8_MMA(0, 1, At, B1); PG8_BAR; PG8_SCHED;
            PG8_LDA(At, 0, 1); PG8_STAGE(PG8_SB(0, 0), b2h0, voffB[0], voffB[1]); PG8_STAGE(PG8_SB(0, 1), b2h1, voffB[0], voffB[1]);
            PG8_WAIT_V(6); PG8_WAIT_L(0); PG8_BAR; PG8_MMA(1, 0, At, B0); PG8_MMA(1, 1, At, B1); PG8_BAR; PG8_SCHED;
            PG8_LDB(B0, 1, 0); PG8_LDB(B1, 1, 1); PG8_SCHED; PG8_LDA(At, 1, 0); PG8_STAGE(PG8_SA(0, 0), a2h0, v00, v01); PG8_STAGE(PG8_SA(0, 1), a2h1, v10, v11);
            PG8_WAIT_V(8); PG8_WAIT_L(0); PG8_BAR; PG8_MMA(0, 0, At, B0); PG8_MMA(0, 1, At, B1); PG8_BAR; PG8_SCHED;
            PG8_LDA(At, 1, 1); PG8_STAGE(PG8_SB(1, 0), b3h0, voffB[0], voffB[1]); PG8_STAGE(PG8_SB(1, 1), b3h1, voffB[0], voffB[1]);
            PG8_WAIT_V(6); PG8_WAIT_L(0); PG8_BAR; PG8_MMA(1, 0, At, B0); PG8_MMA(1, 1, At, B1); PG8_BAR; PG8_SCHED;
        }
        if (wr == 0) PG8_BAR;
        if constexpr (Prob::FP8) asm volatile("s_nop 15\n\ts_nop 15" ::: "memory");
        P.epi(acc, cur, wr, wc, fr, fq);
        if (!has_next) break;
#pragma unroll
        for (int a = 0; a < 2; ++a)
#pragma unroll
            for (int b = 0; b < 2; ++b)
#pragma unroll
                for (int m = 0; m < 4; ++m)
#pragma unroll
                    for (int n = 0; n < 2; ++n) acc[a][b][m][n] = (f32x4){0.f, 0.f, 0.f, 0.f};
        cur = nxt; cA0 = nA0; cA1 = nA1; cB0 = nB0; cB1 = nB1; ++ui;
        if constexpr (Prob::GATHER) { c00 = n00; c01 = n01; c10 = n10; c11 = n11; }
        if (wr == 1) PG8_BAR;
    }
    PG8_WAIT_V(0);
    PG8_BAR;
#undef PG8_SA
#undef PG8_SB
#undef PG8_STAGE
#undef PG8_LD8
#undef PG8_LDA
#undef PG8_LDB
#undef PG8_MMA
#undef PG8_WAIT_V
#undef PG8_WAIT_L
#undef PG8_BAR
#undef PG8_SCHED
}
}

using pg8::Unit; using pg8::Acc;
struct ProbIn {
    static constexpr bool PERM = true, GATHER = false, FP8 = false, PERM64 = false;
    int K; pg8::DenseOrder S; const bf16* A; const bf16* Bt; bf16* Z; const float* bqkv;
    __device__ __forceinline__ bool next(int i, Unit& u) const { return S.next(i, u); }
    __device__ __forceinline__ const char* a_base(const Unit& u, int h) const { return (const char*)A + (size_t)(u.pm * 256 + h * 128) * K * 2; }
    __device__ __forceinline__ const char* b_base(const Unit& u, int h) const { return (const char*)Bt + (size_t)(u.pn * 256 + h * 128) * K * 2; }
    __device__ __forceinline__ void epi(const Acc& acc, const Unit& u, int wr, int wc, int fr, int fq) const {
        const int row0 = u.pm * 256 + wr * 64 + fr, col0 = u.pn * 256 + wc * 32 + 8 * fq;
        const int mode = u.pn < 13 ? 0 : 1;
        f32x4 bv[2][2];
#pragma unroll
        for (int bj = 0; bj < 2; ++bj)
#pragma unroll
            for (int n = 0; n < 2; ++n) bv[bj][n] = (mode == 1) ? *(const f32x4*)(bqkv + (col0 - ZC_Q) + bj * 128 + 4 * n) : (f32x4){0.f, 0.f, 0.f, 0.f};
#pragma unroll
        for (int ai = 0; ai < 2; ++ai)
#pragma unroll
            for (int m = 0; m < 4; ++m) { bf16* rowp = Z + (size_t)(row0 + ai * 128 + m * 16) * IN_COLS + col0;
#pragma unroll
                for (int bj = 0; bj < 2; ++bj) { f32x4 v0 = acc[ai][bj][m][0] + bv[bj][0], v1 = acc[ai][bj][m][1] + bv[bj][1];
                    v4u w; w.x = pk2(v0[0], v0[1]); w.y = pk2(v0[2], v0[3]); w.z = pk2(v1[0], v1[1]); w.w = pk2(v1[2], v1[3]);
                    *(v4u*)(rowp + bj * 128) = w; } }
    }
};
struct ProbInG {
    static constexpr bool PERM = true, GATHER = false, FP8 = true, PERM64 = false;
    int K; pg8::BalancedOrder S; const unsigned char* A; const unsigned char* Bt; bf16* Z;
    __device__ __forceinline__ bool next(int i, Unit& u) const { return S.next(i, u); }
    __device__ __forceinline__ const char* a_base(const Unit& u, int h) const { return (const char*)A + (size_t)(u.pm * 256 + h * 128) * K; }
    __device__ __forceinline__ const char* b_base(const Unit& u, int h) const { return (const char*)Bt + (size_t)(u.pn * 256 + h * 128) * K; }
    __device__ __forceinline__ void epi(const Acc& acc, const Unit& u, int wr, int wc, int fr, int fq) const {
        const int row0 = u.pm * 256 + wr * 64 + fr, col0 = ZC_GR + u.pn * 256 + wc * 32 + 8 * fq;
#pragma unroll
        for (int ai = 0; ai < 2; ++ai)
#pragma unroll
            for (int m = 0; m < 4; ++m) { bf16* rowp = Z + (size_t)(row0 + ai * 128 + m * 16) * IN_COLS + col0;
#pragma unroll
                for (int bj = 0; bj < 2; ++bj) { f32x4 v0 = acc[ai][bj][m][0], v1 = acc[ai][bj][m][1];
#pragma unroll
                    for (int j = 0; j < 4; ++j) { v0[j] = sigmoidf_(v0[j]); v1[j] = sigmoidf_(v1[j]); }
                    v4u w; w.x = pk2(v0[0], v0[1]); w.y = pk2(v0[2], v0[3]); w.z = pk2(v1[0], v1[1]); w.w = pk2(v1[2], v1[3]);
                    *(v4u*)(rowp + bj * 128) = w; } }
    }
};
template <int MODE> struct ProbUp {
    static constexpr bool PERM = true, GATHER = false, FP8 = true, PERM64 = false;
    int K; pg8::DenseOrder S; const bf16* A; const bf16* Bt; const bf16* Z; const bf16* T1in; bf16* O;
    __device__ __forceinline__ bool next(int i, Unit& u) const { return S.next(i, u); }
    __device__ __forceinline__ const char* a_base(const Unit& u, int h) const { return (const char*)A + (size_t)(u.pm * 256 + h * 128) * K; }
    __device__ __forceinline__ const char* b_base(const Unit& u, int h) const { return (const char*)Bt + (size_t)(u.pn * 256 + h * 128) * K; }
    __device__ __forceinline__ void epi(const Acc& acc, const Unit& u, int wr, int wc, int fr, int fq) const {
        const int row0 = u.pm * 256 + wr * 64 + fr, col0 = u.pn * 256 + wc * 32 + 8 * fq;
#pragma unroll
        for (int ai = 0; ai < 2; ++ai)
#pragma unroll
            for (int m = 0; m < 4; ++m) { const size_t r = (size_t)(row0 + ai * 128 + m * 16);
#pragma unroll
                for (int bj = 0; bj < 2; ++bj) { const int col = col0 + bj * 128;
                    const v4u g = *(const v4u*)(Z + r * IN_COLS + (MODE == 0 ? ZC_GR : ZC_GA) + col);
                    f32x4 v0 = acc[ai][bj][m][0], v1 = acc[ai][bj][m][1];
                    v0[0] *= bflo(g.x); v0[1] *= bfhi(g.x); v0[2] *= bflo(g.y); v0[3] *= bfhi(g.y); v1[0] *= bflo(g.z); v1[1] *= bfhi(g.z); v1[2] *= bflo(g.w); v1[3] *= bfhi(g.w);
                    if (MODE == 1) { const v4u t = *(const v4u*)(T1in + r * D + col);
                        v0[0] += bflo(t.x); v0[1] += bfhi(t.x); v0[2] += bflo(t.y); v0[3] += bfhi(t.y); v1[0] += bflo(t.z); v1[1] += bfhi(t.z); v1[2] += bflo(t.w); v1[3] += bfhi(t.w); }
                    if (MODE == 1) { v2u w8; w8.x = pk4_fp8(v0[0], v0[1], v0[2], v0[3]); w8.y = pk4_fp8(v1[0], v1[1], v1[2], v1[3]); *(v2u*)((unsigned char*)O + r * D + col) = w8; }
                    else { v4u w; w.x = pk2(v0[0], v0[1]); w.y = pk2(v0[2], v0[3]); w.z = pk2(v1[0], v1[1]); w.w = pk2(v1[2], v1[3]);
                        *(v4u*)(O + r * D + col) = w; } } }
    }
};
struct ProbOut {
    static constexpr bool PERM = true, GATHER = false, FP8 = true, PERM64 = false;
    int K; pg8::DenseOrder S; const bf16* A; const bf16* Bt; const float* X; bf16* O;
    __device__ __forceinline__ bool next(int i, Unit& u) const { return S.next(i, u); }
    __device__ __forceinline__ const char* a_base(const Unit& u, int h) const { return (const char*)A + (size_t)(u.pm * 256 + h * 128) * K; }
    __device__ __forceinline__ const char* b_base(const Unit& u, int h) const { return (const char*)Bt + (size_t)(u.pn * 256 + h * 128) * K; }
    __device__ __forceinline__ void epi(const Acc& acc, const Unit& u, int wr, int wc, int fr, int fq) const {
        const int row0 = u.pm * 256 + wr * 64 + fr, col0 = u.pn * 256 + wc * 32 + 8 * fq;
#pragma unroll
        for (int ai = 0; ai < 2; ++ai)
#pragma unroll
            for (int m = 0; m < 4; ++m) { const size_t off = (size_t)(row0 + ai * 128 + m * 16) * D + col0;
#pragma unroll
                for (int bj = 0; bj < 2; ++bj) { const f32x4 x0 = *(const f32x4*)(X + off + bj * 128), x1v = *(const f32x4*)(X + off + bj * 128 + 4);
                    const f32x4 v0 = x0 + acc[ai][bj][m][0], v1 = x1v + acc[ai][bj][m][1];
                    v4u w; w.x = pk2(v0[0], v0[1]); w.y = pk2(v0[2], v0[3]); w.z = pk2(v1[0], v1[1]); w.w = pk2(v1[2], v1[3]);
                    *(v4u*)(O + off + bj * 128) = w; } }
    }
};
struct ProbMoe1 {
    static constexpr bool PERM = true, GATHER = true, FP8 = true, PERM64 = false;
    int K; pg8::MoeOrder<16> S; const unsigned char* H2; const unsigned char* W1t; const float* b1; const int* tokslot; unsigned char* ACT; const float* rss;
    __device__ __forceinline__ bool next(int i, Unit& u) const { return S.next(i, u); }
    __device__ __forceinline__ const char* a_base(const Unit& u, int h) const { return (const char*)H2; }
    __device__ __forceinline__ const char* b_base(const Unit& u, int h) const { return (const char*)W1t + ((size_t)u.e * 4096 + (size_t)h * 2048 + (size_t)u.pn * 128) * K; }
    __device__ __forceinline__ unsigned gather(const Unit& u, int h, int R) const { return (unsigned)tokslot[u.pm * 256 + h * 128 + R] * (unsigned)K; }
    __device__ __forceinline__ void epi(const Acc& acc, const Unit& u, int wr, int wc, int fr, int fq) const {
        const int row0 = u.pm * 256 + wr * 64 + fr, colg = u.pn * 128 + wc * 32 + 8 * fq;
        const float* bp = b1 + (size_t)u.e * 4096 + colg;
        const f32x4 bg0 = *(const f32x4*)(bp), bg1 = *(const f32x4*)(bp + 4), bl0 = *(const f32x4*)(bp + 2048) + 1.0f, bl1 = *(const f32x4*)(bp + 2048 + 4) + 1.0f;
        float rsv[2][4];
#pragma unroll
        for (int ai = 0; ai < 2; ++ai)
#pragma unroll
            for (int m = 0; m < 4; ++m) rsv[ai][m] = rss[row0 + ai * 128 + m * 16];
#pragma unroll
        for (int ai = 0; ai < 2; ++ai)
#pragma unroll
            for (int m = 0; m < 4; ++m) {
                float o[8];
                const f32x2 rs2 = (f32x2){rsv[ai][m], rsv[ai][m]};
#pragma unroll
                for (int n = 0; n < 2; ++n)
#pragma unroll
                    for (int jp = 0; jp < 2; ++jp) {
                        const f32x4 ag = acc[ai][0][m][n], al = acc[ai][1][m][n], bg = n ? bg1 : bg0, bl = n ? bl1 : bl0;
                        f32x2 g = (f32x2){ag[2 * jp], ag[2 * jp + 1]} * rs2 + (f32x2){bg[2 * jp], bg[2 * jp + 1]};
                        f32x2 l1 = (f32x2){al[2 * jp], al[2 * jp + 1]} * rs2 + (f32x2){bl[2 * jp], bl[2 * jp + 1]};
                        g.x = fminf(g.x, 7.0f); g.y = fminf(g.y, 7.0f); l1.x = fminf(fmaxf(l1.x, -6.0f), 8.0f); l1.y = fminf(fmaxf(l1.y, -6.0f), 8.0f);
                        const f32x2 t = g * (-1.702f * 1.44269504f);
                        f32x2 d = (f32x2){__builtin_amdgcn_exp2f(t.x), __builtin_amdgcn_exp2f(t.y)} + 1.0f;
                        const f32x2 r = (f32x2){__builtin_amdgcn_rcpf(d.x), __builtin_amdgcn_rcpf(d.y)};
                        const f32x2 ov = g * r * l1;
                        o[n * 4 + 2 * jp] = ov.x; o[n * 4 + 2 * jp + 1] = ov.y; }
                v2u w; w.x = pk4_fp8(o[0], o[1], o[2], o[3]); w.y = pk4_fp8(o[4], o[5], o[6], o[7]);
                *(v2u*)(ACT + (size_t)(row0 + ai * 128 + m * 16) * DFF + colg) = w; }
    }
};
struct ProbMoe2 {
    static constexpr bool PERM = true, GATHER = false, FP8 = true, PERM64 = true;
    int K; pg8::MoeOrder<8> S; const unsigned char* ACT; const unsigned char* W2t; const float* b2; unsigned char* Y;
    __device__ __forceinline__ bool next(int i, Unit& u) const { return S.next(i, u); }
    __device__ __forceinline__ const char* a_base(const Unit& u, int h) const { return (const char*)ACT + (size_t)(u.pm * 256 + h * 128) * K; }
    __device__ __forceinline__ const char* b_base(const Unit& u, int h) const { return (const char*)W2t + ((size_t)u.e * 2048 + (size_t)u.pn * 256 + (size_t)h * 8) * K; }
    __device__ __forceinline__ void epi(const Acc& acc, const Unit& u, int wr, int wc, int fr, int fq) const {
        const int row0 = u.pm * 256 + wr * 64 + fr, col0 = u.pn * 256 + wc * 64 + 16 * fq;
        f32x4 bv[2][2];
#pragma unroll
        for (int bj = 0; bj < 2; ++bj)
#pragma unroll
            for (int n = 0; n < 2; ++n) bv[bj][n] = *(const f32x4*)(b2 + (size_t)u.e * D + col0 + bj * 8 + 4 * n);
#pragma unroll
        for (int ai = 0; ai < 2; ++ai)
#pragma unroll
            for (int m = 0; m < 4; ++m) { unsigned char* rowp = Y + (size_t)(row0 + ai * 128 + m * 16) * D + col0;
                const f32x4 v00 = acc[ai][0][m][0] + bv[0][0], v01 = acc[ai][0][m][1] + bv[0][1], v10 = acc[ai][1][m][0] + bv[1][0], v11 = acc[ai][1][m][1] + bv[1][1];
                v4u w; w.x = pk4_fp8(v00[0], v00[1], v00[2], v00[3]); w.y = pk4_fp8(v01[0], v01[1], v01[2], v01[3]); w.z = pk4_fp8(v10[0], v10[1], v10[2], v10[3]); w.w = pk4_fp8(v11[0], v11[1], v11[2], v11[3]);
                *(v4u*)rowp = w; }
    }
};

__device__ __forceinline__ void p0_transpose_item(const float* W, int K, int N, bf16* WT, LAS float* scr, int item, int lane) {
    const int nblk = N / 32, kb = item / nblk, nb = item % nblk, k0 = 64 * kb, n0 = 32 * nb;
#pragma unroll 8
    for (int i = 0; i < 32; ++i) { const int kk = 2 * i + (lane >> 5); scr[kk * 33 + (lane & 31)] = W[(size_t)(k0 + kk) * N + n0 + (lane & 31)]; }
    LDS_WAIT(); asm volatile("" ::: "memory");
    const int c = lane & 7;
#pragma unroll
    for (int j = 0; j < 4; ++j) { const int n = (lane >> 3) + 8 * j; const LAS float* s = scr + (8 * c) * 33 + n;
        v4u o; o.x = pk2(s[0 * 33], s[1 * 33]); o.y = pk2(s[2 * 33], s[3 * 33]); o.z = pk2(s[4 * 33], s[5 * 33]); o.w = pk2(s[6 * 33], s[7 * 33]);
        *(v4u*)(WT + (size_t)(n0 + n) * K + k0 + 8 * c) = o; }
    LDS_WAIT(); asm volatile("" ::: "memory");
}
struct Cvt64 { f32x4 v[16]; };
__device__ __forceinline__ void cvt64_load(Cvt64& q, const float* W, int N, int item, int lane) {
    const int nblk = N / 64, kb = item / nblk, nb = item % nblk, k0 = 64 * kb, n0 = 64 * nb, c4 = lane & 15, kr = lane >> 4;
#pragma unroll
    for (int i = 0; i < 16; ++i) q.v[i] = *(const f32x4*)(W + (size_t)(k0 + 4 * i + kr) * N + n0 + 4 * c4);
}
__device__ __forceinline__ void cvt64_store(const Cvt64& q, int K, int N, unsigned char* WT, LAS float* scr, int item, int lane, const float* kscale = nullptr) {
    const int nblk = N / 64, kb = item / nblk, nb = item % nblk, k0 = 64 * kb, n0 = 64 * nb, c4 = lane & 15, kr = lane >> 4;
#pragma unroll
    for (int i = 0; i < 16; ++i) { const int k = 4 * i + kr; const float sc = kscale ? 64.f * kscale[k0 + k] : 64.f;
        *(LAS f32x4*)(scr + k * 64 + 4 * (c4 ^ (k & 15) ^ ((k >> 4) << 2))) = q.v[i] * sc; }
    LDS_WAIT(); asm volatile("" ::: "memory");
    const int kc = lane & 3;
#pragma unroll
    for (int j = 0; j < 4; ++j) { const int n = (lane >> 2) + 16 * j; float f[16];
#pragma unroll
        for (int i = 0; i < 16; ++i) { const int k = 16 * kc + i; f[i] = scr[k * 64 + 4 * ((n >> 2) ^ (k & 15) ^ ((k >> 4) << 2)) + (n & 3)]; }
        v4u o; o.x = pk4_fp8(f[0], f[1], f[2], f[3]); o.y = pk4_fp8(f[4], f[5], f[6], f[7]); o.z = pk4_fp8(f[8], f[9], f[10], f[11]); o.w = pk4_fp8(f[12], f[13], f[14], f[15]);
        *(v4u*)(WT + (size_t)(n0 + n) * K + k0 + 16 * kc) = o; }
    LDS_WAIT(); asm volatile("" ::: "memory");
}
__device__ __forceinline__ void p0_transpose_item_fp8(const float* W, int K, int N, unsigned char* WT, LAS float* scr, int item, int lane) {
    const int nblk = N / 32, kb = item / nblk, nb = item % nblk, k0 = 64 * kb, n0 = 32 * nb;
#pragma unroll 8
    for (int i = 0; i < 32; ++i) { const int kk = 2 * i + (lane >> 5); scr[kk * 33 + (lane & 31)] = W[(size_t)(k0 + kk) * N + n0 + (lane & 31)]; }
    LDS_WAIT(); asm volatile("" ::: "memory");
    const int c = lane & 3;
#pragma unroll
    for (int j = 0; j < 2; ++j) { const int n = (lane >> 2) + 16 * j; const LAS float* s = scr + (16 * c) * 33 + n;
        v4u o; o.x = pk4_fp8(64.f * s[0 * 33], 64.f * s[1 * 33], 64.f * s[2 * 33], 64.f * s[3 * 33]); o.y = pk4_fp8(64.f * s[4 * 33], 64.f * s[5 * 33], 64.f * s[6 * 33], 64.f * s[7 * 33]);
        o.z = pk4_fp8(64.f * s[8 * 33], 64.f * s[9 * 33], 64.f * s[10 * 33], 64.f * s[11 * 33]); o.w = pk4_fp8(64.f * s[12 * 33], 64.f * s[13 * 33], 64.f * s[14 * 33], 64.f * s[15 * 33]);
        *(v4u*)(WT + (size_t)(n0 + n) * K + k0 + 16 * c) = o; }
    LDS_WAIT(); asm volatile("" ::: "memory");
}
__device__ __forceinline__ void rms_row_to_bf16(const float* xrow, const float* g, bf16* orow, int lane, unsigned* orow8 = nullptr) {
    const f32x4* xr = (const f32x4*)xrow + lane; const f32x4* gr = (const f32x4*)g + lane;
    f32x4 v[8]; float s = 0.f;
#pragma unroll
    for (int j = 0; j < 8; ++j) { v[j] = xr[64 * j]; s += (v[j].x * v[j].x + v[j].y * v[j].y) + (v[j].z * v[j].z + v[j].w * v[j].w); }
    const float rstd = 1.0f / sqrtf(wave_sum(s) * (1.f / D) + NORM_EPS);
    v2u* o8 = (v2u*)orow + lane;
#pragma unroll
    for (int j = 0; j < 8; ++j) { const f32x4 gg = gr[64 * j]; const float h0 = v[j].x * rstd * gg.x, h1 = v[j].y * rstd * gg.y, h2 = v[j].z * rstd * gg.z, h3 = v[j].w * rstd * gg.w;
        v2u w; w.x = pk2(h0, h1); w.y = pk2(h2, h3); o8[64 * j] = w; if (orow8) orow8[lane + 64 * j] = pk4_fp8(h0, h1, h2, h3); }
}

struct Args { const float* in[27]; float* out; unsigned char* ws; int ph_lo, ph_hi, li, pad; };
enum { I_X = 0, I_N1G, I_WIN, I_MU, I_W0, I_WDEC, I_A0, I_WICLR, I_WGATE, I_KK, I_KA, I_RK, I_LNG, I_LNB, I_BQKV, I_SINK, I_WUPR, I_WUPA, I_WOUT, I_N2G, I_WR, I_BR, I_W1, I_B1, I_W2, I_B2, I_NFG };
constexpr int NPHASE = 14;

__device__ __forceinline__ float dpp_xor1(float x) { return __builtin_bit_cast(float, __builtin_amdgcn_mov_dpp(__builtin_bit_cast(int, x), 0xB1, 0xF, 0xF, true)); }
__device__ __forceinline__ float dpp_xor2(float x) { return __builtin_bit_cast(float, __builtin_amdgcn_mov_dpp(__builtin_bit_cast(int, x), 0x4E, 0xF, 0xF, true)); }
__device__ __forceinline__ float dpp_hmir(float x) { return __builtin_bit_cast(float, __builtin_amdgcn_mov_dpp(__builtin_bit_cast(int, x), 0x141, 0xF, 0xF, true)); }
__device__ __forceinline__ float dpp_rmir(float x) { return __builtin_bit_cast(float, __builtin_amdgcn_mov_dpp(__builtin_bit_cast(int, x), 0x140, 0xF, 0xF, true)); }
__device__ __forceinline__ float red8(float x) { x += dpp_xor1(x); x += dpp_xor2(x); x += dpp_hmir(x); return x; }

__device__ __forceinline__ void cvt_experts(const Args& args, unsigned char* W1T, unsigned char* W2T, LAS float* scr, int lane, int first, int end, int stride) {
    constexpr int I_E1 = 32 * 64, I_E2 = 32 * 32;
#define CVT_SRC(it) ((it) < 32 * I_E1 ? args.in[I_W1] + (size_t)((it) / I_E1) * 2048 * 4096 : args.in[I_W2] + (size_t)(((it) - 32 * I_E1) / I_E2) * 2048 * 2048)
#define CVT_DST(it) ((it) < 32 * I_E1 ? W1T + (size_t)((it) / I_E1) * 4096 * 2048 : W2T + (size_t)(((it) - 32 * I_E1) / I_E2) * 2048 * 2048)
#define CVT_N(it) ((it) < 32 * I_E1 ? 4096 : 2048)
#define CVT_SUB(it) ((it) < 32 * I_E1 ? (it) % I_E1 : ((it) - 32 * I_E1) % I_E2)
    Cvt64 qa, qb; int ia = first, ib = first + stride;
    if (ia < end) cvt64_load(qa, CVT_SRC(ia), CVT_N(ia), CVT_SUB(ia), lane);
    while (ia < end) {
        if (ib < end) cvt64_load(qb, CVT_SRC(ib), CVT_N(ib), CVT_SUB(ib), lane);
        cvt64_store(qa, 2048, CVT_N(ia), CVT_DST(ia), scr, CVT_SUB(ia), lane, (ia < 32 * I_E1) ? args.in[I_N2G] : nullptr);
        ia = ib + stride;
        if (ib >= end) break;
        if (ia < end) cvt64_load(qa, CVT_SRC(ia), CVT_N(ia), CVT_SUB(ia), lane);
        cvt64_store(qb, 2048, CVT_N(ib), CVT_DST(ib), scr, CVT_SUB(ib), lane, (ib < 32 * I_E1) ? args.in[I_N2G] : nullptr);
        ib = ia + stride;
    }
#undef CVT_SRC
#undef CVT_DST
#undef CVT_N
#undef CVT_SUB
}

__global__ void __launch_bounds__(512, 2) fwd(Args args) {
    extern __shared__ __attribute__((aligned(16))) unsigned char lds_raw[];
    LAS unsigned char* lds = (LAS unsigned char*)lds_raw;
    volatile LAS unsigned* MISC = (volatile LAS unsigned*)(lds + MISC_OFF);
    LAS int* TAB = (LAS int*)(lds + TAB_OFF);
    const int tid = threadIdx.x, lane = tid & 63, wave = __builtin_amdgcn_readfirstlane(tid >> 6);
    const int G = gridDim.x, bx = blockIdx.x;
    const int vcu = (G % 8 == 0) ? (bx % 8) * (G / 8) + bx / 8 : bx;
    unsigned char* ws = args.ws;
    unsigned* ctl = (unsigned*)(ws + WS_CTL);
    for (int u = tid; u < 64; u += 512) MISC[u] = 0u;
    __syncthreads();
#if MK_N_LAUNCHES == 1
    XcdBarrier bar = xcd_barrier_post(ctl + CW_BAR + args.li * XCD_BAR_WORDS, MISC + 8);
#define GRID_BAR() xcd_barrier(bar)
#else
#define GRID_BAR() do {} while (0)
#endif
    const int lo = args.ph_lo, hi = args.ph_hi;
#define IN(k) (lo <= (k) && (k) < hi)
#define BOTH(k) (IN(k) && IN((k) + 1))
    const float* x = args.in[I_X];
    bf16* WinT = (bf16*)(ws + WS_WIN_T); bf16* WuprT = (bf16*)(ws + WS_WUPR_T); bf16* WupaT = (bf16*)(ws + WS_WUPA_T); bf16* WoutT = (bf16*)(ws + WS_WOUT_T);
    bf16* WdT = (bf16*)(ws + WS_WD_T); bf16* WiT = (bf16*)(ws + WS_WI_T); bf16* WgT = (bf16*)(ws + WS_WG_T);
    unsigned char* W1T = ws + WS_W1_T; unsigned char* W2T = ws + WS_W2_T;
    unsigned char* H8 = ws + WS_H;
    bf16* Hb = (bf16*)(ws + WS_H); bf16* Z = (bf16*)(ws + WS_Z);
    unsigned char* scb = ws + WS_SCAN;
    bf16* S_R = (bf16*)(scb + SC_R); bf16* S_KF = (bf16*)(scb + SC_KF); bf16* S_V = (bf16*)(scb + SC_V); bf16* S_AN = (bf16*)(scb + SC_AN); bf16* S_BN = (bf16*)(scb + SC_BN); bf16* S_G = (bf16*)(scb + SC_G);
    float* S_LW = (float*)(scb + SC_LW); bf16* S_QR = (bf16*)(scb + SC_QR); float* S_YL = (float*)(scb + SC_YL); bf16* S_E = (bf16*)(scb + SC_E); float* S_HP = (float*)(scb + SC_HP);
    bf16* PST = (bf16*)(ws + WS_PST); float* GAMg = (float*)(ws + WS_GAM); float* BDg = (float*)(ws + WS_BD);
    bf16* YR = (bf16*)(ws + WS_YR); bf16* YA = (bf16*)(ws + WS_YA); bf16* T1 = (bf16*)(ws + WS_T1); bf16* MG = (bf16*)(ws + WS_MG);
    unsigned char* ACT = ws + WS_ACT; unsigned char* Yb = ws + WS_Y;
    int* topi = (int*)(ws + WS_TOPI); float* topg = (float*)(ws + WS_TOPG); int* slotof = (int*)(ws + WS_SLOT);
    int* tokslot = (int*)(ctl + CW_TOKSLOT);
    bf16* X1 = (bf16*)(ws + WS_X1); bf16* WrS = (bf16*)(ws + WS_WRT); float* rss = (float*)(ctl + CW_RSS);
    float* rstd_tok = (float*)(ws + WS_BD);
    unsigned* cntw = ctl + CW_CNT + args.li * 256;
    const int gw = vcu * 8 + wave, NGW = G * 8;

    if (IN(0)) {
        LAS float* scr = (LAS float*)(lds + wave * 16384);
        constexpr int I_IN = 32 * 152, I_UP = 16 * 64, I_OUT = 32 * 64, I_E1 = 32 * 64, I_E2 = 32 * 32;
        constexpr int NITEMS = I_IN + 2 * I_UP + I_OUT + 128;
        for (int it = gw; it < NITEMS; it += NGW) {
            int r = it;
            if (r < I_IN) { p0_transpose_item(args.in[I_WIN], 2048, IN_COLS, WinT, scr, (r / 152) * 280 + (r % 152), lane); continue; } r -= I_IN;
            if (r < I_UP) { if (r < 16 * 32) { Cvt64 q; cvt64_load(q, args.in[I_WUPR], 2048, r, lane); cvt64_store(q, 1024, 2048, (unsigned char*)WuprT, scr, r, lane); } continue; } r -= I_UP;
            if (r < I_UP) { if (r < 16 * 32) { Cvt64 q; cvt64_load(q, args.in[I_WUPA], 2048, r, lane); cvt64_store(q, 1024, 2048, (unsigned char*)WupaT, scr, r, lane); } continue; } r -= I_UP;
            if (r < I_OUT) { if (r < 32 * 32) { Cvt64 q; cvt64_load(q, args.in[I_WOUT], 2048, r, lane); cvt64_store(q, 2048, 2048, (unsigned char*)WoutT, scr, r, lane); } continue; } r -= I_OUT;
            if (r < 32) { p0_transpose_item(args.in[I_WDEC], 64, 1024, WdT, scr, r, lane); continue; } r -= 32;
            if (r < 32) { p0_transpose_item(args.in[I_WICLR], 64, 1024, WiT, scr, r, lane); continue; } r -= 32;
            p0_transpose_item(args.in[I_WGATE], 128, 1024, WgT, scr, r, lane);
        }
        for (int it = gw; it < 32 * 64; it += NGW) { Cvt64 q; const int item = (it >> 6) * (IN_COLS / 64) + (it & 63);
            cvt64_load(q, args.in[I_WIN] + ZC_GR, IN_COLS, item, lane); cvt64_store(q, 2048, IN_COLS, ws + WS_WING, scr, item, lane); }
        for (int i = bx * 512 + tid; i < 32 * 2048; i += G * 512) { const int e = i >> 11, k = i & 2047; const float w = args.in[I_N2G][k] * args.in[I_WR][k * 32 + e];
            const unsigned h = f2bf(w); const float r1 = w - __builtin_bit_cast(float, h << 16); const unsigned m = f2bf(r1); const float r2 = r1 - __builtin_bit_cast(float, m << 16);
            WrS[i] = (bf16)h; WrS[65536 + i] = (bf16)m; WrS[131072 + i] = (bf16)f2bf(r2); }
        for (int m = gw; m < NT; m += NGW) rms_row_to_bf16(x + (size_t)m * D, args.in[I_N1G], Hb + (size_t)m * D, lane, (unsigned*)(ws + WS_H1F + (size_t)m * D));
        if (BOTH(0)) GRID_BAR();
    }
    if (IN(1)) {
        const bool split = (G % 16 == 0);
        const int role = split ? ((bx >> 3) & 1) : 0, rank = split ? ((bx >> 4) * 8 + (bx & 7)) : bx, GG = split ? G / 2 : G;
        const int cfirst = (split ? rank : vcu) * 8 + wave, cstride = GG * 8;
        constexpr int NEI = 32 * 32 * 64 + 32 * 32 * 32, NEI1 = 92 * 1024;
        const int nei1 = split ? NEI1 : NEI;
        if (!split || role == 1) cvt_experts(args, W1T, W2T, (LAS float*)(lds + wave * 16384), lane, cfirst, nei1, cstride);
        if (!split || role == 1) { __syncthreads(); ProbInG Pg; Pg.K = 2048; Pg.S.init(NT, IN_COLS - ZC_GR, GG, rank, 0, 0); Pg.A = ws + WS_H1F; Pg.Bt = ws + WS_WING; Pg.Z = Z; pg8::gemm_phase(lds, Pg); }
        if (!split || role == 0) { ProbIn P; P.K = 2048; P.S.init(NT, ZC_GR, GG, rank); P.A = Hb; P.Bt = WinT; P.Z = Z; P.bqkv = args.in[I_BQKV]; pg8::gemm_phase(lds, P);
            if (split) { __syncthreads(); cvt_experts(args, W1T, W2T, (LAS float*)(lds + wave * 16384), lane, NEI1 + cfirst, NEI, cstride); } }
        if (BOTH(1)) GRID_BAR();
    }
    if (IN(2)) {
        {
            constexpr int XS = 528;
            LAS unsigned char* XL = lds; LAS float* NRM = (LAS float*)(lds + 64 * XS);
            LAS float* PRM = (LAS float*)(lds + 40960);
            for (int idx = tid; idx < 7 * 1024; idx += 512) { const int ar = idx >> 10, c = idx & 1023;
                PRM[idx] = ar == 0 ? args.in[I_W0][c] : ar == 1 ? args.in[I_A0][c] : ar == 2 ? args.in[I_KK][c] : ar == 3 ? args.in[I_KA][c] : ar == 4 ? args.in[I_MU][ZC_R + c] : ar == 5 ? args.in[I_MU][ZC_K + c] : args.in[I_MU][ZC_V + c]; }
            const float* mu = args.in[I_MU]; const float* kkp = args.in[I_KK];
            const int fr = lane & 15, fq = lane >> 4;
            for (int un = bx; un < NT / 64; un += G) {
                const size_t t0 = (size_t)un * 64;
                __syncthreads();
#pragma unroll
                for (int i = 0; i < 4; ++i) {
                    const int idx = tid + 512 * i, tok = idx >> 5, c8 = idx & 31, col = ZC_LORA + 8 * c8; const size_t t = t0 + tok;
                    const v4u cw = *(const v4u*)(Z + t * IN_COLS + col); v4u pw = (v4u){0u, 0u, 0u, 0u}; if (t % SEQ != 0) pw = *(const v4u*)(Z + (t - 1) * IN_COLS + col);
                    const f32x4 m0 = *(const f32x4*)(mu + col), m1 = *(const f32x4*)(mu + col + 4);
                    float xv[8]; const unsigned cu[4] = {cw.x, cw.y, cw.z, cw.w}, pu[4] = {pw.x, pw.y, pw.z, pw.w};
#pragma unroll
                    for (int j = 0; j < 4; ++j) { const float ml = j < 2 ? m0[2 * j] : m1[2 * j - 4], mh = j < 2 ? m0[2 * j + 1] : m1[2 * j - 3];
                        xv[2 * j] = bflo(cu[j]) + (bflo(pu[j]) - bflo(cu[j])) * ml; xv[2 * j + 1] = bfhi(cu[j]) + (bfhi(pu[j]) - bfhi(cu[j])) * mh; }
                    if (c8 < 8) {
#pragma unroll
                        for (int j = 0; j < 8; ++j) xv[j] = 1.0f - 2.0f * __builtin_amdgcn_rcpf(1.0f + __expf(2.0f * xv[j])); }
                    else if (c8 >= 16) {
#pragma unroll
                        for (int j = 0; j < 8; ++j) xv[j] = sigmoidf_(xv[j]); }
                    *(LAS v4u*)(XL + tok * XS + c8 * 16) = (v4u){pk2(xv[0], xv[1]), pk2(xv[2], xv[3]), pk2(xv[4], xv[5]), pk2(xv[6], xv[7])};
                }
#pragma unroll 4
                for (int i = 0; i < 16; ++i) {
                    const int pr = (tid >> 3) + 64 * i, tok = pr >> 4, hd = pr & 15, ch = hd * 64 + 8 * (tid & 7); const size_t t = t0 + tok;
                    const v4u cw = *(const v4u*)(Z + t * IN_COLS + ZC_K + ch); v4u pw = (v4u){0u, 0u, 0u, 0u}; if (t % SEQ != 0) pw = *(const v4u*)(Z + (t - 1) * IN_COLS + ZC_K + ch);
                    const LAS float* pp = PRM + ch;
                    const f32x4 m0 = *(const LAS f32x4*)(pp + 5120), m1 = *(const LAS f32x4*)(pp + 5124), k0 = *(const LAS f32x4*)(pp + 2048), k1 = *(const LAS f32x4*)(pp + 2052);
                    const unsigned cu[4] = {cw.x, cw.y, cw.z, cw.w}, pu[4] = {pw.x, pw.y, pw.z, pw.w};
                    float ss = 0.f;
#pragma unroll
                    for (int j = 0; j < 4; ++j) { const float ml = j < 2 ? m0[2 * j] : m1[2 * j - 4], mh = j < 2 ? m0[2 * j + 1] : m1[2 * j - 3], kl = j < 2 ? k0[2 * j] : k1[2 * j - 4], kh = j < 2 ? k0[2 * j + 1] : k1[2 * j - 3];
                        const float a = (bflo(cu[j]) + (bflo(pu[j]) - bflo(cu[j])) * ml) * kl, bq = (bfhi(cu[j]) + (bfhi(pu[j]) - bfhi(cu[j])) * mh) * kh; ss += a * a + bq * bq; }
                    ss = red8(ss);
                    if ((tid & 7) == 0) NRM[tok * 16 + hd] = 1.0f / fmaxf(sqrtf(ss), 1e-12f);
                }
                __syncthreads();
                for (int cp = 0; cp < 4; ++cp) {
                    const int c0 = 128 * wave + 32 * cp, hd = c0 >> 6, ch8 = c0 + 8 * fq;
                    bf16x8 wd[2][2], wi[2][2], wg[2][4];
#pragma unroll
                    for (int ab = 0; ab < 2; ++ab) { const int chr = c0 + 8 * (fr >> 2) + 4 * ab + (fr & 3);
#pragma unroll
                        for (int ks = 0; ks < 2; ++ks) { wd[ab][ks] = *(const bf16x8*)(WdT + chr * 64 + 32 * ks + 8 * fq); wi[ab][ks] = *(const bf16x8*)(WiT + chr * 64 + 32 * ks + 8 * fq); }
#pragma unroll
                        for (int ks = 0; ks < 4; ++ks) wg[ab][ks] = *(const bf16x8*)(WgT + chr * 128 + 32 * ks + 8 * fq); }
                    v4u zpf[2][4];
#define PREP_ZLOAD(q, tt_) do { const size_t t_ = t0 + 16 * (tt_) + fr; const bf16* zr_ = Z + t_ * IN_COLS + ch8; \
                        q[0] = *(const v4u*)(zr_ + ZC_K); q[1] = *(const v4u*)(zr_ + ZC_V); q[2] = (v4u){0u, 0u, 0u, 0u}; q[3] = q[2]; \
                        if (t_ % SEQ != 0) { q[2] = *(const v4u*)(zr_ - IN_COLS + ZC_K); q[3] = *(const v4u*)(zr_ - IN_COLS + ZC_V); } } while (0)
                    PREP_ZLOAD(zpf[0], 0);
#pragma unroll
                    for (int tt = 0; tt < 4; ++tt) {
                        asm volatile("" ::: "memory");
                        if (tt + 1 < 4) PREP_ZLOAD(zpf[(tt + 1) & 1], tt + 1);
                        asm volatile("" ::: "memory");
                        const int tok = 16 * tt + fr; const size_t t = t0 + tok;
                        f32x4 dw[2], da[2], dg[2];
#pragma unroll
                        for (int ab = 0; ab < 2; ++ab) { dw[ab] = (f32x4){0.f, 0.f, 0.f, 0.f}; da[ab] = dw[ab]; dg[ab] = dw[ab]; }
#pragma unroll
                        for (int ks = 0; ks < 8; ++ks) { const bf16x8 xb = *(const LAS bf16x8*)(XL + tok * XS + (32 * ks + 8 * fq) * 2);
#pragma unroll
                            for (int ab = 0; ab < 2; ++ab) {
                                if (ks < 2) dw[ab] = __builtin_amdgcn_mfma_f32_16x16x32_bf16(wd[ab][ks], xb, dw[ab], 0, 0, 0);
                                else if (ks < 4) da[ab] = __builtin_amdgcn_mfma_f32_16x16x32_bf16(wi[ab][ks - 2], xb, da[ab], 0, 0, 0);
                                else dg[ab] = __builtin_amdgcn_mfma_f32_16x16x32_bf16(wg[ab][ks - 4], xb, dg[ab], 0, 0, 0); } }
                        const v4u ck4 = zpf[tt & 1][0], cv4 = zpf[tt & 1][1], pk4 = zpf[tt & 1][2], pv4 = zpf[tt & 1][3];
                        const float inrm = NRM[tok * 16 + hd];
                        unsigned q_kf[4], q_v[4], q_an[4], q_bn[4], q_g[4]; float o_lw[8];
#pragma unroll
                        for (int ab = 0; ab < 2; ++ab) {
                            asm volatile("" ::: "memory");
                            const LAS float* pp = PRM + ch8 + 4 * ab;
                            const f32x4 pw0 = *(const LAS f32x4*)(pp), pa0 = *(const LAS f32x4*)(pp + 1024), pkk = *(const LAS f32x4*)(pp + 2048), pka = *(const LAS f32x4*)(pp + 3072),
                                        pmk = *(const LAS f32x4*)(pp + 5120), pmv = *(const LAS f32x4*)(pp + 6144);
                            const unsigned cku[2] = {ab ? ck4.z : ck4.x, ab ? ck4.w : ck4.y}, cvu[2] = {ab ? cv4.z : cv4.x, ab ? cv4.w : cv4.y}, pku[2] = {ab ? pk4.z : pk4.x, ab ? pk4.w : pk4.y}, pvu[2] = {ab ? pv4.z : pv4.x, ab ? pv4.w : pv4.y};
                            float e_kf[4], e_v[4], e_an[4], e_bn[4];
#pragma unroll
                            for (int j = 0; j < 4; ++j) { const int w = j >> 1; const bool hi = j & 1;
                                const float kc = hi ? bfhi(cku[w]) : bflo(cku[w]), kp2 = hi ? bfhi(pku[w]) : bflo(pku[w]), vc = hi ? bfhi(cvu[w]) : bflo(cvu[w]), vp2 = hi ? bfhi(pvu[w]) : bflo(pvu[w]);
                                const float kx = kc + (kp2 - kc) * pmk[j];
                                const float a = sigmoidf_(pa0[j] + da[ab][j]); const float kk = kx * pkk[j] * inrm;
                                o_lw[4 * ab + j] = -0.60653066f * sigmoidf_(pw0[j] + dw[ab][j]);
                                e_kf[j] = kx * (1.0f + (a - 1.0f) * pka[j]); e_v[j] = vc + (vp2 - vc) * pmv[j]; e_an[j] = -kk; e_bn[j] = kk * a; }
                            q_kf[2 * ab] = pk2(e_kf[0], e_kf[1]); q_kf[2 * ab + 1] = pk2(e_kf[2], e_kf[3]);
                            q_v[2 * ab] = pk2(e_v[0], e_v[1]); q_v[2 * ab + 1] = pk2(e_v[2], e_v[3]); q_an[2 * ab] = pk2(e_an[0], e_an[1]); q_an[2 * ab + 1] = pk2(e_an[2], e_an[3]);
                            q_bn[2 * ab] = pk2(e_bn[0], e_bn[1]); q_bn[2 * ab + 1] = pk2(e_bn[2], e_bn[3]); q_g[2 * ab] = pk2(dg[ab][0], dg[ab][1]); q_g[2 * ab + 1] = pk2(dg[ab][2], dg[ab][3]);
                        }
                        const size_t o = t * C + ch8;
                        *(v4u*)(S_KF + o) = (v4u){q_kf[0], q_kf[1], q_kf[2], q_kf[3]}; *(v4u*)(S_V + o) = (v4u){q_v[0], q_v[1], q_v[2], q_v[3]};
                        *(v4u*)(S_AN + o) = (v4u){q_an[0], q_an[1], q_an[2], q_an[3]}; *(v4u*)(S_BN + o) = (v4u){q_bn[0], q_bn[1], q_bn[2], q_bn[3]}; *(v4u*)(S_G + o) = (v4u){q_g[0], q_g[1], q_g[2], q_g[3]};
                        *(v4u*)((bf16*)S_LW + o) = (v4u){pk2(o_lw[0], o_lw[1]), pk2(o_lw[2], o_lw[3]), pk2(o_lw[4], o_lw[5]), pk2(o_lw[6], o_lw[7])};
                    }
                }
            }
        }
#undef PREP_ZLOAD
        if (BOTH(2)) GRID_BAR();
    }
    if (IN(3)) {
        constexpr int MS = 144;
        constexpr int LA_R = 0, LA_B = 9216, LA_AT = 18432, LA_BT = 27648, LA_ARB = 36864, LA_AKVT = 46080,
                      LA_AABH = 55296  , LA_DG = 64512  , LA_DH = 69632  ,
                      LA_GAM = 72704, LA_A = 73728, LA_K = 82944, LA_KT = 92160, LA_VT = 101376, LA_AAK = 110592, LA_ARK = 119808, LA_SEG = LA_AABH;
        const int rb = wave >> 1, cb0 = 2 * (wave & 1);
#define FRAG(off, row, kb) (*(const LAS bf16x8*)(lds + (off) + (row) * MS + (kb)))
#define PROD2(acc, XO, YO) do { _Pragma("unroll") for (int ks = 0; ks < 2; ++ks) { const bf16x8 a_ = FRAG(XO, 16 * rb + fr, 16 * fq + 64 * ks); \
            _Pragma("unroll") for (int n = 0; n < 2; ++n) { const bf16x8 b_ = FRAG(YO, 16 * (cb0 + n) + fr, 16 * fq + 64 * ks); acc[n] = __builtin_amdgcn_mfma_f32_16x16x32_bf16(a_, b_, acc[n], 0, 0, 0); } } } while (0)
        const float* rkp = args.in[I_RK];
        bf16 pr_[9], pk_[8], pv_[8], pa_[8], pb_[8], pl_[8];
        if (bx < 512 * 16) { const size_t g0 = ((size_t)(bx >> 4) * 64 + 8 * wave) * C + (bx & 15) * 64 + lane;
            { const size_t tr0 = (size_t)(bx >> 4) * 64 + 8 * wave; const int cz = ZC_R + (bx & 15) * 64 + lane;
#pragma unroll
              for (int j = 0; j < 9; ++j) pr_[j] = ((tr0 + j) % SEQ == 0 && j == 0) ? (bf16)0 : Z[(tr0 + j - 1) * IN_COLS + cz]; }
#pragma unroll
            for (int j = 0; j < 8; ++j) { const size_t o = g0 + (size_t)j * C; pk_[j] = S_KF[o]; pv_[j] = S_V[o]; pa_[j] = S_AN[o]; pb_[j] = S_BN[o]; pl_[j] = ((const bf16*)S_LW)[o]; } }
        for (int un = bx; un < 512 * 16; un += G) {
            const int h = un & 15, tb = un >> 4; const size_t t0 = (size_t)tb * 64;
            int ln = lane; asm volatile("" : "+v"(ln));
            const int fr = ln & 15, fq = ln >> 4;
            __syncthreads();
            {
                float r8[8], k8[8], v8[8], a8[8], b8[8], lw8[8], cs[8];
                const float mur_ = args.in[I_MU][ZC_R + h * 64 + ln], rkv = rkp[h * 64 + ln];
#pragma unroll
                for (int j = 0; j < 8; ++j) { const float rc_ = bf1(pr_[j + 1]), rp_ = bf1(pr_[j]); r8[j] = rc_ + (rp_ - rc_) * mur_; k8[j] = bf1(pk_[j]); v8[j] = bf1(pv_[j]); a8[j] = bf1(pa_[j]); b8[j] = bf1(pb_[j]); lw8[j] = bf1(pl_[j]); }
                {
                    const int un2 = (un + G < 512 * 16) ? un + G : un;
                    const size_t g2 = ((size_t)(un2 >> 4) * 64 + 8 * wave) * C + (un2 & 15) * 64 + ln;
                    { const size_t tr2 = (size_t)(un2 >> 4) * 64 + 8 * wave; const int cz2 = ZC_R + (un2 & 15) * 64 + ln;
#pragma unroll
                      for (int j = 0; j < 9; ++j) pr_[j] = ((tr2 + j) % SEQ == 0 && j == 0) ? (bf16)0 : Z[(tr2 + j - 1) * IN_COLS + cz2]; }
#pragma unroll
                    for (int j = 0; j < 8; ++j) { const size_t o = g2 + (size_t)j * C; pk_[j] = S_KF[o]; pv_[j] = S_V[o]; pa_[j] = S_AN[o]; pb_[j] = S_BN[o]; pl_[j] = ((const bf16*)S_LW)[o]; }
                }
                cs[0] = lw8[0];
#pragma unroll
                for (int j = 1; j < 8; ++j) cs[j] = cs[j - 1] + lw8[j];
                ((LAS float*)(lds + LA_SEG))[wave * 64 + ln] = cs[7];
                {
                    float x4[4], x2[2], x1;
                    const bool b0 = ln & 1, b1 = ln & 2, b2 = ln & 4;
#pragma unroll
                    for (int i = 0; i < 4; ++i) { const float e = r8[2 * i] * k8[2 * i] * rkv, o = r8[2 * i + 1] * k8[2 * i + 1] * rkv; x4[i] = (b0 ? o : e) + dpp_xor1(b0 ? e : o); }
#pragma unroll
                    for (int i = 0; i < 2; ++i) { const float e = x4[2 * i], o = x4[2 * i + 1]; x2[i] = (b1 ? o : e) + dpp_xor2(b1 ? e : o); }
                    { const float e = x2[0], o = x2[1]; x1 = (b2 ? o : e) + __shfl_xor(b2 ? e : o, 4); }
                    x1 += __shfl_xor(x1, 8); x1 += __shfl_xor(x1, 16); x1 += __shfl_xor(x1, 32);
                    if (ln < 8) BDg[(t0 + 8 * wave + ln) * 16 + h] = x1;
                }
                __syncthreads();
                float pre = 0.f, tot = 0.f;
#pragma unroll
                for (int s = 0; s < 8; ++s) { const float xx = ((LAS float*)(lds + LA_SEG))[s * 64 + ln]; tot += xx; pre += (s < wave) ? xx : 0.f; }
                unsigned pa[4], pb[4], pk[4], pv[4];
#pragma unroll
                for (int j2 = 0; j2 < 4; ++j2) {
                    float Rf[2], Af[2], Bf[2], Kf[2];
#pragma unroll
                    for (int u = 0; u < 2; ++u) { const int j = 2 * j2 + u; const float cum = pre + cs[j], ec = __expf(cum), en = __expf(-cum), ep = __expf(cum - lw8[j]);
                        Rf[u] = r8[j] * ec; Af[u] = a8[j] * ep; Bf[u] = b8[j] * en; Kf[u] = k8[j] * en; }
                    const unsigned Rw = pk2(Rf[0], Rf[1]), Aw = pk2(Af[0], Af[1]), Bw = pk2(Bf[0], Bf[1]), Kw = pk2(Kf[0], Kf[1]);
                    pa[j2] = Aw; pb[j2] = Bw; pk[j2] = Kw; pv[j2] = (__builtin_bit_cast(unsigned, v8[2 * j2]) >> 16) | (__builtin_bit_cast(unsigned, v8[2 * j2 + 1]) & 0xffff0000u);
                    const int t = 8 * wave + 2 * j2;
                    *(LAS bf16*)(lds + LA_R + t * MS + ln * 2) = (bf16)(Rw & 0xffffu); *(LAS bf16*)(lds + LA_R + (t + 1) * MS + ln * 2) = (bf16)(Rw >> 16);
                    *(LAS bf16*)(lds + LA_A + t * MS + ln * 2) = (bf16)(Aw & 0xffffu); *(LAS bf16*)(lds + LA_A + (t + 1) * MS + ln * 2) = (bf16)(Aw >> 16);
                    *(LAS bf16*)(lds + LA_B + t * MS + ln * 2) = (bf16)(Bw & 0xffffu); *(LAS bf16*)(lds + LA_B + (t + 1) * MS + ln * 2) = (bf16)(Bw >> 16);
                    *(LAS bf16*)(lds + LA_K + t * MS + ln * 2) = (bf16)(Kw & 0xffffu); *(LAS bf16*)(lds + LA_K + (t + 1) * MS + ln * 2) = (bf16)(Kw >> 16);
                }
                *(LAS v4u*)(lds + LA_AT + ln * MS + wave * 16) = (v4u){pa[0], pa[1], pa[2], pa[3]};
                *(LAS v4u*)(lds + LA_BT + ln * MS + wave * 16) = (v4u){pb[0], pb[1], pb[2], pb[3]};
                *(LAS v4u*)(lds + LA_KT + ln * MS + wave * 16) = (v4u){pk[0], pk[1], pk[2], pk[3]};
                *(LAS v4u*)(lds + LA_VT + ln * MS + wave * 16) = (v4u){pv[0], pv[1], pv[2], pv[3]};
                if (wave == 0) { const float gl = __expf(tot); ((LAS float*)(lds + LA_GAM))[ln] = gl; GAMg[(size_t)un * 64 + ln] = gl; }
            }
            __syncthreads();
            {
                f32x4 cab[2], cak[2], crb[2], crk[2];
#pragma unroll
                for (int n = 0; n < 2; ++n) { cab[n] = (f32x4){0.f, 0.f, 0.f, 0.f}; cak[n] = cab[n]; crb[n] = cab[n]; crk[n] = cab[n]; }
#pragma unroll
                for (int ks = 0; ks < 2; ++ks) { const bf16x8 aA = FRAG(LA_A, 16 * rb + fr, 16 * fq + 64 * ks), aR = FRAG(LA_R, 16 * rb + fr, 16 * fq + 64 * ks);
#pragma unroll
                    for (int n = 0; n < 2; ++n) { const bf16x8 bB = FRAG(LA_B, 16 * (cb0 + n) + fr, 16 * fq + 64 * ks), bK = FRAG(LA_K, 16 * (cb0 + n) + fr, 16 * fq + 64 * ks);
                        cab[n] = __builtin_amdgcn_mfma_f32_16x16x32_bf16(aA, bB, cab[n], 0, 0, 0); cak[n] = __builtin_amdgcn_mfma_f32_16x16x32_bf16(aA, bK, cak[n], 0, 0, 0);
                        crb[n] = __builtin_amdgcn_mfma_f32_16x16x32_bf16(aR, bB, crb[n], 0, 0, 0); crk[n] = __builtin_amdgcn_mfma_f32_16x16x32_bf16(aR, bK, crk[n], 0, 0, 0); } }
#pragma unroll
                for (int n = 0; n < 2; ++n)
#pragma unroll
                    for (int rg = 0; rg < 4; ++rg) { const int t = 16 * rb + 4 * fq + rg, s = 16 * (cb0 + n) + fr;
                        const float vab = (s < t) ? cab[n][rg] : 0.f;
                        *(LAS bf16*)(lds + LA_AABH + t * MS + s * 2) = (bf16)f2bf(vab);
                        if (rb == cb0 + n) ((LAS float*)(lds + LA_DG))[rb * 320 + (4 * fq + rg) * 20 + fr] = vab;
                        *(LAS bf16*)(lds + LA_AAK + t * MS + s * 2) = (bf16)((s < t) ? f2bf(cak[n][rg]) : 0u);
                        *(LAS bf16*)(lds + LA_ARB + t * MS + s * 2) = (bf16)((s <= t) ? f2bf(crb[n][rg]) : 0u);
                        *(LAS bf16*)(lds + LA_ARK + t * MS + s * 2) = (bf16)((s <= t) ? f2bf(crk[n][rg]) : 0u); }
            }
            __syncthreads();
            f32x4 accY[2], accH[2];
            {
                f32x4 ckv[2];
#pragma unroll
                for (int n = 0; n < 2; ++n) { ckv[n] = (f32x4){0.f, 0.f, 0.f, 0.f}; accY[n] = ckv[n]; accH[n] = ckv[n]; }
                PROD2(ckv, LA_AAK, LA_VT); PROD2(accY, LA_ARK, LA_VT); PROD2(accH, LA_KT, LA_VT);
#pragma unroll
                for (int n = 0; n < 2; ++n) { v2u w; w.x = pk2(ckv[n][0], ckv[n][1]); w.y = pk2(ckv[n][2], ckv[n][3]);
                    *(LAS v2u*)(lds + LA_AKVT + (16 * (cb0 + n) + fr) * MS + (16 * rb + 4 * fq) * 2) = w; }
                if (wave == 7) {
                    const int blk = ln >> 4, cc = ln & 15; const LAS float* Ad = (const LAS float*)(lds + LA_DG) + blk * 320;
                    float wc[16];
#pragma unroll
                    for (int t = 0; t < 16; ++t) { float a_ = (t == cc) ? 1.0f : 0.0f;
#pragma unroll
                        for (int s4 = 0; s4 < (t + 3) / 4; ++s4) { const f32x4 av = *(const LAS f32x4*)(Ad + t * 20 + s4 * 4);
#pragma unroll
                            for (int q = 0; q < 4; ++q) if (s4 * 4 + q < t) a_ += av[q] * wc[s4 * 4 + q]; }
                        wc[t] = a_; }
#pragma unroll
                    for (int t = 0; t < 16; ++t) *(LAS bf16*)(lds + LA_DH + blk * 768 + t * 48 + cc * 2) = (bf16)f2bf(wc[t]);
                }
            }
            __syncthreads();
            {
                LAS unsigned char* xb = lds + (wave < 4 ? LA_AT + 16 * wave * MS : LA_AKVT + 16 * (wave - 4) * MS);
                const bf16x8 zf = (bf16x8){0, 0, 0, 0, 0, 0, 0, 0};
#pragma unroll
                for (int i = 0; i < 4; ++i) {
                    LAS unsigned char* zp = xb + fr * MS + (16 * i + 4 * fq) * 2;
                    const v2u xw = *(const LAS v2u*)zp;
                    f32x4 y = (f32x4){bflo(xw.x), bfhi(xw.x), bflo(xw.y), bfhi(xw.y)};
#pragma unroll
                    for (int ks = 0; ks < (i + 1) / 2; ++ks) {
                        const bool live = (8 * fq + 32 * ks) < 16 * i;
                        bf16x8 a_ = FRAG(LA_AABH, 16 * i + fr, 16 * fq + 64 * ks), b_ = *(const LAS bf16x8*)(xb + fr * MS + 16 * fq + 64 * ks);
                        if (!live) { a_ = zf; b_ = zf; }
                        y = __builtin_amdgcn_mfma_f32_16x16x32_bf16(a_, b_, y, 0, 0, 0);
                    }
                    v2u yw; yw.x = pk2(y[0], y[1]); yw.y = pk2(y[2], y[3]);
                    const v2u dw = *(const LAS v2u*)(lds + LA_DH + i * 768 + fr * 48 + fq * 8);
                    const f32x4 z = __builtin_amdgcn_mfma_f32_16x16x16bf16_1k(__builtin_bit_cast(s16x4, dw), __builtin_bit_cast(s16x4, yw), (f32x4){0.f, 0.f, 0.f, 0.f}, 0, 0, 0);
                    v2u zw; zw.x = pk2(z[0], z[1]); zw.y = pk2(z[2], z[3]);
                    *(LAS v2u*)zp = zw;
                    asm volatile("s_waitcnt lgkmcnt(0)" ::: "memory");
                }
            }
            __syncthreads();
            {
                PROD2(accY, LA_ARB, LA_AKVT);
                PROD2(accH, LA_BT, LA_AKVT);
                f32x4 cE[2], cQ[2];
#pragma unroll
                for (int n = 0; n < 2; ++n) { cE[n] = (f32x4){0.f, 0.f, 0.f, 0.f};
                    const v2u rr = *(const LAS v2u*)(lds + LA_R + (16 * (cb0 + n) + fr) * MS + (16 * rb + 4 * fq) * 2);
                    cQ[n] = (f32x4){bflo(rr.x), bfhi(rr.x), bflo(rr.y), bfhi(rr.y)}; }
                PROD2(cE, LA_AT, LA_BT);
                PROD2(cQ, LA_AT, LA_ARB);
                const size_t ib = (size_t)un * 4096;
#pragma unroll
                for (int n = 0; n < 2; ++n) {
                    { v2u wy; wy.x = pk2(accY[n][0], accY[n][1]); wy.y = pk2(accY[n][2], accY[n][3]); *(v2u*)((bf16*)S_YL + ib + (size_t)(((rb * 4 + cb0 + n) * 64 + ln) * 4)) = wy; }
                    const float gj = ((const LAS float*)(lds + LA_GAM))[16 * (cb0 + n) + fr];
                    f32x4 gv;
#pragma unroll
                    for (int rg = 0; rg < 4; ++rg) gv[rg] = gj * (cE[n][rg] + ((16 * (cb0 + n) + fr) == (16 * rb + 4 * fq + rg) ? 1.0f : 0.0f));
                    v2u we; we.x = pk2(gv[0], gv[1]); we.y = pk2(gv[2], gv[3]);
                    *(v2u*)(S_E + ib + (size_t)((16 * (cb0 + n) + fr) * 64 + 16 * rb + 4 * fq)) = we;
                    v2u wq; wq.x = pk2(cQ[n][0], cQ[n][1]); wq.y = pk2(cQ[n][2], cQ[n][3]);
                    *(v2u*)(S_QR + (t0 + 16 * (cb0 + n) + fr) * C + h * 64 + 16 * rb + 4 * fq) = wq;
                }
                {
                    const f32x4 g4 = *(const LAS f32x4*)(lds + LA_GAM + (16 * rb + 4 * fq) * 4);
                    v4u wh; wh.x = pk2(g4[0] * accH[0][0], g4[1] * accH[0][1]); wh.y = pk2(g4[2] * accH[0][2], g4[3] * accH[0][3]); wh.z = pk2(g4[0] * accH[1][0], g4[1] * accH[1][1]); wh.w = pk2(g4[2] * accH[1][2], g4[3] * accH[1][3]);
                    *(v4u*)((bf16*)S_HP + ib + (size_t)(((rb * 2 + (wave & 1)) * 64 + ln) * 8)) = wh;
                }
            }
        }
#undef PROD2
        if (BOTH(3)) GRID_BAR();
    }
    if (IN(4)) {
        constexpr int MS = 144;
        const int rb = wave >> 1, cb0 = 2 * (wave & 1), fr = lane & 15, fq = lane >> 4, wodd = wave & 1;
        bf16* GCg = (bf16*)(ws + WS_GC); bf16* HCg = (bf16*)(ws + WS_HC);
        struct Ops { bf16x8 e0, e1; v4u hh, h2; };
#define PB_LOAD(q, Gb, Hb, ix) do { const size_t ib_ = (size_t)(ix) * 4096; \
            q.e0 = *(const bf16x8*)((Gb) + ib_ + (16 * rb + fr) * 64 + 8 * fq); q.e1 = *(const bf16x8*)((Gb) + ib_ + (16 * rb + fr) * 64 + 8 * fq + 32); \
            q.hh = *(const v4u*)((Hb) + ib_ + ((rb * 2 + wodd) * 64 + lane) * 8); } while (0)
#define PB_STEP(q, ix, par) do { LAS unsigned char* PT = lds + ((par) & 1) * 9216; \
            _Pragma("unroll") for (int n = 0; n < 2; ++n) { v2u w; w.x = pk2(Pst[n][0], Pst[n][1]); w.y = pk2(Pst[n][2], Pst[n][3]); \
                *(LAS v2u*)(PT + (16 * (cb0 + n) + fr) * MS + (16 * rb + 4 * fq) * 2) = w; } \
            asm volatile("s_waitcnt lgkmcnt(0)" ::: "memory"); __builtin_amdgcn_s_barrier(); asm volatile("" ::: "memory"); \
            *(v4u*)(PST + (size_t)(ix) * 4096 + (tid >> 3) * 64 + (tid & 7) * 8) = *(const LAS v4u*)(PT + (tid >> 3) * MS + (tid & 7) * 16); \
            f32x4 acc0 = (f32x4){bflo(q.hh.x), bfhi(q.hh.x), bflo(q.hh.y), bfhi(q.hh.y)}, acc1 = (f32x4){bflo(q.hh.z), bfhi(q.hh.z), bflo(q.hh.w), bfhi(q.hh.w)}; \
            { const bf16x8 b00 = *(const LAS bf16x8*)(PT + (16 * cb0 + fr) * MS + 16 * fq), b10 = *(const LAS bf16x8*)(PT + (16 * (cb0 + 1) + fr) * MS + 16 * fq); \
              const bf16x8 b01 = *(const LAS bf16x8*)(PT + (16 * cb0 + fr) * MS + 16 * fq + 64), b11 = *(const LAS bf16x8*)(PT + (16 * (cb0 + 1) + fr) * MS + 16 * fq + 64); \
              acc0 = __builtin_amdgcn_mfma_f32_16x16x32_bf16(q.e0, b00, acc0, 0, 0, 0); acc1 = __builtin_amdgcn_mfma_f32_16x16x32_bf16(q.e0, b10, acc1, 0, 0, 0); \
              acc0 = __builtin_amdgcn_mfma_f32_16x16x32_bf16(q.e1, b01, acc0, 0, 0, 0); acc1 = __builtin_amdgcn_mfma_f32_16x16x32_bf16(q.e1, b11, acc1, 0, 0, 0); } \
            Pst[0] = acc0; Pst[1] = acc1; } while (0)
        for (int tk = bx; tk < 512; tk += G) {
            const int chain = tk >> 4, g = tk & 15, b = chain >> 4, h = chain & 15;
            if (g == 15) continue;
            f32x4 Sst[4];
#pragma unroll
            for (int n = 0; n < 4; ++n)
#pragma unroll
                for (int rg = 0; rg < 4; ++rg) Sst[n][rg] = (!wodd && (16 * rb + 4 * fq + rg) == (16 * n + fr)) ? 1.0f : 0.0f;
            Ops qa[8], qb[8];
#define IT(cc) ((size_t)(b * 256 + 16 * g + (cc)) * 16 + h)
#define B1_LOAD(q, cc) do { PB_LOAD(q, S_E, (const bf16*)S_HP, IT(cc)); q.hh = *(const v4u*)((const bf16*)S_HP + IT(cc) * 4096 + ((rb * 2 + 0) * 64 + lane) * 8); q.h2 = *(const v4u*)((const bf16*)S_HP + IT(cc) * 4096 + ((rb * 2 + 1) * 64 + lane) * 8); } while (0)
#define B1_STEP(q, par) do { LAS unsigned char* PT = lds + ((par) & 1) * 18432; \
                _Pragma("unroll") for (int n = 0; n < 4; ++n) { v2u w; w.x = pk2(Sst[n][0], Sst[n][1]); w.y = pk2(Sst[n][2], Sst[n][3]); \
                    *(LAS v2u*)(PT + (16 * (4 * wodd + n) + fr) * MS + (16 * rb + 4 * fq) * 2) = w; } \
                asm volatile("s_waitcnt lgkmcnt(0)" ::: "memory"); __builtin_amdgcn_s_barrier(); asm volatile("" ::: "memory"); \
                f32x4 ac[4]; const unsigned hw[8] = {q.hh.x, q.hh.y, q.hh.z, q.hh.w, q.h2.x, q.h2.y, q.h2.z, q.h2.w}; \
                _Pragma("unroll") for (int n = 0; n < 4; ++n) ac[n] = wodd ? (f32x4){bflo(hw[2 * n]), bfhi(hw[2 * n]), bflo(hw[2 * n + 1]), bfhi(hw[2 * n + 1])} : (f32x4){0.f, 0.f, 0.f, 0.f}; \
                _Pragma("unroll") for (int n = 0; n < 4; ++n) { const LAS unsigned char* br = PT + (16 * (4 * wodd + n) + fr) * MS + 16 * fq; \
                    ac[n] = __builtin_amdgcn_mfma_f32_16x16x32_bf16(q.e0, *(const LAS bf16x8*)br, ac[n], 0, 0, 0); ac[n] = __builtin_amdgcn_mfma_f32_16x16x32_bf16(q.e1, *(const LAS bf16x8*)(br + 64), ac[n], 0, 0, 0); } \
                _Pragma("unroll") for (int n = 0; n < 4; ++n) Sst[n] = ac[n]; } while (0)
            __syncthreads();
#pragma unroll
            for (int j = 0; j < 8; ++j) B1_LOAD(qa[j], j);
#pragma unroll
            for (int j = 0; j < 4; ++j) B1_STEP(qa[j], j);
#pragma unroll
            for (int j = 0; j < 4; ++j) B1_LOAD(qb[j], 8 + j);
#pragma unroll
            for (int j = 4; j < 8; ++j) B1_STEP(qa[j], j);
#pragma unroll
            for (int j = 4; j < 8; ++j) B1_LOAD(qb[j], 8 + j);
#pragma unroll
            for (int j = 0; j < 8; ++j) B1_STEP(qb[j], j);
#undef B1_LOAD
#undef B1_STEP
            if (!wodd) {
#pragma unroll
                for (int n = 0; n < 4; ++n)
#pragma unroll
                    for (int rg = 0; rg < 4; ++rg) GCg[(size_t)tk * 4096 + (16 * rb + 4 * fq + rg) * 64 + 16 * n + fr] = (bf16)f2bf(Sst[n][rg]);
            } else {
#pragma unroll
                for (int p = 0; p < 2; ++p) { v4u w; w.x = pk2(Sst[2 * p][0], Sst[2 * p][1]); w.y = pk2(Sst[2 * p][2], Sst[2 * p][3]); w.z = pk2(Sst[2 * p + 1][0], Sst[2 * p + 1][1]); w.w = pk2(Sst[2 * p + 1][2], Sst[2 * p + 1][3]);
                    *(v4u*)(HCg + (size_t)tk * 4096 + ((rb * 2 + p) * 64 + lane) * 8) = w; }
            }
        }
        GRID_BAR();
        if (bx < 32) {
            const int b = bx >> 4, h = bx & 15;
            f32x4 Pst[2]; Pst[0] = (f32x4){0.f, 0.f, 0.f, 0.f}; Pst[1] = Pst[0];
            Ops qa[8], qb[8];
            __syncthreads();
#pragma unroll
            for (int j = 0; j < 8; ++j) PB_LOAD(qa[j], GCg, HCg, bx * 16 + j);
#pragma unroll
            for (int j = 0; j < 4; ++j) PB_STEP(qa[j], (size_t)(b * 256 + 16 * j) * 16 + h, j);
#pragma unroll
            for (int j = 0; j < 4; ++j) PB_LOAD(qb[j], GCg, HCg, bx * 16 + 8 + j);
#pragma unroll
            for (int j = 4; j < 8; ++j) PB_STEP(qa[j], (size_t)(b * 256 + 16 * j) * 16 + h, j);
#pragma unroll
            for (int j = 4; j < 8; ++j) PB_LOAD(qb[j], GCg, HCg, bx * 16 + (8 + j < 15 ? 8 + j : 14));
#pragma unroll
            for (int j = 0; j < 8; ++j) PB_STEP(qb[j], (size_t)(b * 256 + 16 * (8 + j)) * 16 + h, j);
        }
        {
        {
            constexpr int KS = 144, VS = 528;
            LAS unsigned char* Ks = lds; LAS unsigned char* VT = lds + 36864;
            const int fr = lane & 15, fq = lane >> 4, hg = wave >> 1, qh = wave & 1;
            LAS int* qslot = (LAS int*)(lds + TAB_OFF + 3072);
            int nxq = 0; if (tid == 0) nxq = (int)__hip_atomic_fetch_add(ctl + CW_ATTQ, 1u, RLX_AGENT);
            for (;;) {
                __syncthreads();
                if (tid == 0) *qslot = nxq;
                __syncthreads();
                const int un = *qslot; if (un >= 2 * 128 * 4) break;
                if (tid == 0) nxq = (int)__hip_atomic_fetch_add(ctl + CW_ATTQ, 1u, RLX_AGENT);
                const int g = un & 3, nb = (un >> 2) & 127, b = un >> 9;
                const size_t tq0 = (size_t)b * SEQ + (size_t)nb * 128;
                const int head = g * 4 + hg;
                bf16x8 qf[4][2];
#pragma unroll
                for (int qt = 0; qt < 4; ++qt) { const bf16* qp = Z + (tq0 + 64 * qh + 16 * qt + fr) * IN_COLS + ZC_Q + head * 64 + 8 * fq; qf[qt][0] = *(const bf16x8*)qp; qf[qt][1] = *(const bf16x8*)(qp + 32); }
                {
                    const int key = tid >> 1, hf = tid & 1; const bool ok = (nb > 0) || key >= 128;
                    const bf16* kp = Z + (ok ? tq0 + key - 128 : tq0) * IN_COLS + ZC_KA + g * 64 + hf * 32;
                    const int key2 = tid & 255, dh = tid >> 8; const bool ok2 = (nb > 0) || key2 >= 128;
                    const bf16* vp = Z + (ok2 ? tq0 + key2 - 128 : tq0) * IN_COLS + ZC_VA + g * 64 + dh * 32;
                    v4u kv[4], vv[4];
#pragma unroll
                    for (int c = 0; c < 4; ++c) kv[c] = *(const v4u*)(kp + c * 8);
#pragma unroll
                    for (int c = 0; c < 4; ++c) vv[c] = *(const v4u*)(vp + c * 8);
#pragma unroll
                    for (int c = 0; c < 4; ++c) *(LAS v4u*)(Ks + key * KS + hf * 64 + c * 16) = kv[c];
#pragma unroll
                    for (int c = 0; c < 4; ++c) {
                        LAS unsigned char* wp = VT + (32 * (c & 1) + 8 * dh + 4 * (c >> 1)) * VS + key2 * 2;
                        *(LAS bf16*)(wp + 0 * VS) = (bf16)(vv[c].x & 0xffffu); *(LAS bf16*)(wp + 1 * VS) = (bf16)(vv[c].x >> 16); *(LAS bf16*)(wp + 2 * VS) = (bf16)(vv[c].y & 0xffffu); *(LAS bf16*)(wp + 3 * VS) = (bf16)(vv[c].y >> 16);
                        *(LAS bf16*)(wp + 16 * VS) = (bf16)(vv[c].z & 0xffffu); *(LAS bf16*)(wp + 17 * VS) = (bf16)(vv[c].z >> 16); *(LAS bf16*)(wp + 18 * VS) = (bf16)(vv[c].w & 0xffffu); *(LAS bf16*)(wp + 19 * VS) = (bf16)(vv[c].w >> 16); }
                }
                __syncthreads();
                const float sink = args.in[I_SINK][head];
#pragma unroll
                for (int qt = 0; qt < 4; ++qt) {
                    const int ql0 = 64 * qh + 16 * qt, kt0 = 4 * qh + qt, ql = ql0 + fr;
                    const bf16x8 q0 = qf[qt][0], q1 = qf[qt][1];
                    f32x4 st[9];
#pragma unroll
                    for (int j = 0; j < 9; ++j) { const LAS unsigned char* ka = Ks + (16 * (kt0 + j) + fr) * KS + 16 * fq;
                        st[j] = __builtin_amdgcn_mfma_f32_16x16x32_bf16(*(const LAS bf16x8*)ka, q0, (f32x4){0.f, 0.f, 0.f, 0.f}, 0, 0, 0);
                        st[j] = __builtin_amdgcn_mfma_f32_16x16x32_bf16(*(const LAS bf16x8*)(ka + 64), q1, st[j], 0, 0, 0); }
#pragma unroll
                    for (int rg = 0; rg < 4; ++rg) { if (!(4 * fq + rg > fr)) st[0][rg] = -3.0e38f; if (!(4 * fq + rg <= fr)) st[8][rg] = -3.0e38f; }
                    if (nb == 0) {
#pragma unroll
                        for (int j = 0; j < 9; ++j)
#pragma unroll
                            for (int rg = 0; rg < 4; ++rg) { if (16 * (kt0 + j) + 4 * fq + rg < 128) st[j][rg] = -3.0e38f; }
                    }
                    float mx = -3.0e38f;
#pragma unroll
                    for (int j = 0; j < 9; ++j)
#pragma unroll
                        for (int rg = 0; rg < 4; ++rg) mx = fmaxf(mx, st[j][rg]);
                    mx = fmaxf(mx, __shfl_xor(mx, 16)); mx = fmaxf(mx, __shfl_xor(mx, 32)); mx = fmaxf(mx * 0.125f, sink);
                    const float cs = 0.125f * 1.44269504f, mc = mx * 1.44269504f;
                    float ls = 0.f;
#pragma unroll
                    for (int j = 0; j < 9; ++j)
#pragma unroll
                        for (int rg = 0; rg < 4; ++rg) { const float p = __builtin_amdgcn_exp2f(fmaf(st[j][rg], cs, -mc)); st[j][rg] = p; ls += p; }
                    ls += __shfl_xor(ls, 16); ls += __shfl_xor(ls, 32);
                    const float inv = 1.0f / (ls + __expf(sink - mx));
                    f32x4 ot[4];
#pragma unroll
                    for (int dt = 0; dt < 4; ++dt) ot[dt] = (f32x4){0.f, 0.f, 0.f, 0.f};
#pragma unroll
                    for (int i = 0; i < 5; ++i) {
                        v4u pw; pw.x = pk2(st[2 * i][0], st[2 * i][1]); pw.y = pk2(st[2 * i][2], st[2 * i][3]);
                        if (i < 4) { pw.z = pk2(st[2 * i + 1 < 9 ? 2 * i + 1 : 8][0], st[2 * i + 1 < 9 ? 2 * i + 1 : 8][1]); pw.w = pk2(st[2 * i + 1 < 9 ? 2 * i + 1 : 8][2], st[2 * i + 1 < 9 ? 2 * i + 1 : 8][3]); } else { pw.z = 0u; pw.w = 0u; }
                        const bf16x8 pb = __builtin_bit_cast(bf16x8, pw);
#pragma unroll
                        for (int dt = 0; dt < 4; ++dt) { const LAS unsigned char* vb = VT + (16 * dt + fr) * VS + (16 * (kt0 + 2 * i) + 4 * fq) * 2;
                            const v2u lo = *(const LAS v2u*)vb; v2u hi = (v2u){0u, 0u}; if (i < 4) hi = *(const LAS v2u*)(vb + 32);
                            const bf16x8 va = __builtin_bit_cast(bf16x8, (v4u){lo.x, lo.y, hi.x, hi.y});
                            ot[dt] = __builtin_amdgcn_mfma_f32_16x16x32_bf16(va, pb, ot[dt], 0, 0, 0); }
                    }
                    { v4u w; w.x = pk4_fp8(ot[0][0] * inv, ot[0][1] * inv, ot[0][2] * inv, ot[0][3] * inv); w.y = pk4_fp8(ot[1][0] * inv, ot[1][1] * inv, ot[1][2] * inv, ot[1][3] * inv);
                      w.z = pk4_fp8(ot[2][0] * inv, ot[2][1] * inv, ot[2][2] * inv, ot[2][3] * inv); w.w = pk4_fp8(ot[3][0] * inv, ot[3][1] * inv, ot[3][2] * inv, ot[3][3] * inv);
                      *(v4u*)((unsigned char*)YA + (tq0 + ql0 + fr) * C + head * 64 + 16 * fq) = w; }
                }
            }
        }
                }
        GRID_BAR();
        for (int tk = bx; tk < 512; tk += G) {
            const int chain = tk >> 4, g = tk & 15, b = chain >> 4, h = chain & 15;
            f32x4 Pst[2];
#pragma unroll
            for (int n = 0; n < 2; ++n) { const v2u w = *(const v2u*)(PST + IT(0) * 4096 + (16 * (cb0 + n) + fr) * 64 + 16 * rb + 4 * fq); Pst[n] = (f32x4){bflo(w.x), bfhi(w.x), bflo(w.y), bfhi(w.y)}; }
            Ops qa[8], qb[8];
            __syncthreads();
#pragma unroll
            for (int j = 0; j < 8; ++j) PB_LOAD(qa[j], S_E, (const bf16*)S_HP, IT(j));
#pragma unroll
            for (int j = 0; j < 4; ++j) PB_STEP(qa[j], IT(j), j);
#pragma unroll
            for (int j = 0; j < 4; ++j) PB_LOAD(qb[j], S_E, (const bf16*)S_HP, IT(8 + j));
#pragma unroll
            for (int j = 4; j < 8; ++j) PB_STEP(qa[j], IT(j), j);
#pragma unroll
            for (int j = 4; j < 8; ++j) PB_LOAD(qb[j], S_E, (const bf16*)S_HP, IT(8 + j));
#pragma unroll
            for (int j = 0; j < 8; ++j) PB_STEP(qb[j], IT(8 + j), j);
        }
#undef IT
#undef PB_LOAD
#undef PB_STEP
        if (BOTH(4)) GRID_BAR();
    }
    if (IN(5)) {
        const int fr = lane & 15, fq = lane >> 4;
        LAS float* ybuf = (LAS float*)(lds + wave * 4608);
        const int tl = lane >> 2, c16 = (lane & 3) * 16;
        int hcur = -1; f32x4 lg[4], lb[4];
        for (int task = gw; task < 8192 * 4; task += NGW) {
            const int item = task >> 2, rb = task & 3, h = item & 15, tb = item >> 4; const size_t t0 = (size_t)tb * 64, ib = (size_t)item * 4096;
            if (h != hcur) { hcur = h;
#pragma unroll
                for (int j = 0; j < 4; ++j) { lg[j] = *(const f32x4*)(args.in[I_LNG] + h * 64 + c16 + 4 * j); lb[j] = *(const f32x4*)(args.in[I_LNB] + h * 64 + c16 + 4 * j); } }
            bf16x8 aq[2]; aq[0] = *(const bf16x8*)(S_QR + (t0 + 16 * rb + fr) * C + h * 64 + 8 * fq); aq[1] = *(const bf16x8*)(S_QR + (t0 + 16 * rb + fr) * C + h * 64 + 8 * fq + 32);
            const size_t tt = t0 + 16 * rb + tl;
            const v4u vw0 = *(const v4u*)(S_V + tt * C + h * 64 + c16), vw1 = *(const v4u*)(S_V + tt * C + h * 64 + c16 + 8);
            const v4u gw0 = *(const v4u*)(S_G + tt * C + h * 64 + c16), gw1 = *(const v4u*)(S_G + tt * C + h * 64 + c16 + 8);
            const float bdv = BDg[tt * 16 + h];
            f32x4 acc[4];
#pragma unroll
            for (int cb = 0; cb < 4; ++cb) { const v2u wy = *(const v2u*)((const bf16*)S_YL + ib + ((rb * 4 + cb) * 64 + lane) * 4); acc[cb] = (f32x4){bflo(wy.x), bfhi(wy.x), bflo(wy.y), bfhi(wy.y)}; }
#pragma unroll
            for (int cb = 0; cb < 4; ++cb)
#pragma unroll
                for (int ks = 0; ks < 2; ++ks) { const bf16x8 bp = *(const bf16x8*)(PST + ib + (16 * cb + fr) * 64 + 8 * fq + 32 * ks);
                    acc[cb] = __builtin_amdgcn_mfma_f32_16x16x32_bf16(aq[ks], bp, acc[cb], 0, 0, 0); }
#pragma unroll
            for (int cb = 0; cb < 4; ++cb)
#pragma unroll
                for (int rg = 0; rg < 4; ++rg) ybuf[(4 * fq + rg) * 68 + 16 * cb + fr] = acc[cb][rg];
            LDS_WAIT(); asm volatile("" ::: "memory");
            f32x4 y[4];
#pragma unroll
            for (int j = 0; j < 4; ++j) y[j] = *(const LAS f32x4*)(ybuf + tl * 68 + c16 + 4 * j);
            LDS_WAIT(); asm volatile("" ::: "memory");
            float s = 0.f;
#pragma unroll
            for (int j = 0; j < 4; ++j) s += (y[j][0] + y[j][1]) + (y[j][2] + y[j][3]);
            s += dpp_xor1(s); s += dpp_xor2(s);
            const float mean = s * (1.f / 64.f); float q = 0.f;
#pragma unroll
            for (int j = 0; j < 4; ++j) { y[j] = y[j] - mean; q += (y[j][0] * y[j][0] + y[j][1] * y[j][1]) + (y[j][2] * y[j][2] + y[j][3] * y[j][3]); }
            q += dpp_xor1(q); q += dpp_xor2(q);
            const float rstd = 1.0f / sqrtf(q * (1.f / 64.f) + LNX_EPS);
            const unsigned vu[8] = {vw0.x, vw0.y, vw0.z, vw0.w, vw1.x, vw1.y, vw1.z, vw1.w}, gu[8] = {gw0.x, gw0.y, gw0.z, gw0.w, gw1.x, gw1.y, gw1.z, gw1.w};
            float of[16];
#pragma unroll
            for (int j = 0; j < 8; ++j) { const int a = j >> 1, e0 = (j & 1) * 2;
                of[2 * j] = (y[a][e0] * rstd * lg[a][e0] + lb[a][e0] + bdv * bflo(vu[j])) * bflo(gu[j]);
                of[2 * j + 1] = (y[a][e0 + 1] * rstd * lg[a][e0 + 1] + lb[a][e0 + 1] + bdv * bfhi(vu[j])) * bfhi(gu[j]); }
            *(v4u*)((unsigned char*)YR + tt * C + h * 64 + c16) = (v4u){pk4_fp8(of[0], of[1], of[2], of[3]), pk4_fp8(of[4], of[5], of[6], of[7]), pk4_fp8(of[8], of[9], of[10], of[11]), pk4_fp8(of[12], of[13], of[14], of[15])};
        }
        if (BOTH(5)) GRID_BAR();
    }
#undef FRAG

    if (IN(6)) {
        ProbUp<0> P; P.K = 1024; P.S.init(NT, D, G, bx); P.A = YR; P.Bt = WuprT; P.Z = Z; P.T1in = nullptr; P.O = T1;
        pg8::gemm_phase(lds, P);
        if (BOTH(6)) { VM_WAIT(); __syncthreads(); }
    }
    if (IN(7)) {
        ProbUp<1> P; P.K = 1024; P.S.init(NT, D, G, bx); P.A = YA; P.Bt = WupaT; P.Z = Z; P.T1in = T1; P.O = MG;
        pg8::gemm_phase(lds, P);
        if (BOTH(7)) GRID_BAR();
    }
    if (IN(8)) {
        ProbOut P; P.K = 2048; P.S.init(NT, D, G, bx); P.A = MG; P.Bt = WoutT; P.X = x; P.O = X1;
        pg8::gemm_phase(lds, P);
        if (BOTH(8)) GRID_BAR();
    }
    if (IN(9)) {
        constexpr int RS = 528, WBUF = 96 * RS;
        LAS unsigned* lcnt = (LAS unsigned*)(lds + 2 * WBUF + 1024);
        if (tid < 32) lcnt[tid] = 0u;
        const int fr = lane & 15, fq = lane >> 4;
        const float br0 = args.in[I_BR][fr], br1 = args.in[I_BR][16 + fr];
        for (int base = vcu * 8; base < NT / 16; base += NGW) {
            const int task = base + wave;
            const size_t tok0 = (size_t)task * 16;
            const bf16* xp = X1 + (tok0 + fr) * D + 8 * fq;
            v2u* hp8 = (v2u*)(H8 + (tok0 + fr) * D + 8 * fq);
            f32x4 acc0 = (f32x4){0.f, 0.f, 0.f, 0.f}, acc1 = acc0; float ssq = 0.f;
            v4u wst[6], xc[8];
            __syncthreads();
#pragma unroll
            for (int i = 0; i < 6; ++i) { const int p = tid + 512 * i; wst[i] = *(const v4u*)(WrS + (size_t)(p >> 5) * 2048 + (p & 31) * 8); }
#pragma unroll
            for (int j = 0; j < 8; ++j) xc[j] = *(const v4u*)(xp + 32 * j);
#pragma unroll
            for (int i = 0; i < 6; ++i) { const int p = tid + 512 * i; *(LAS v4u*)(lds + (p >> 5) * RS + (p & 31) * 16) = wst[i]; }
            asm volatile("s_waitcnt lgkmcnt(0)" ::: "memory"); __builtin_amdgcn_s_barrier(); asm volatile("" ::: "memory");
#pragma unroll
            for (int c = 0; c < 8; ++c) {
                const LAS unsigned char* WB = lds + (c & 1) * WBUF;
                v4u xn[8];
                if (c + 1 < 8) {
#pragma unroll
                    for (int i = 0; i < 6; ++i) { const int p = tid + 512 * i; wst[i] = *(const v4u*)(WrS + (size_t)(p >> 5) * 2048 + 256 * (c + 1) + (p & 31) * 8); }
#pragma unroll
                    for (int j = 0; j < 8; ++j) xn[j] = *(const v4u*)(xp + 32 * (8 * (c + 1) + j));
                }
                asm volatile("" ::: "memory");
                bf16x8 wf[2][6];
#pragma unroll
                for (int pp = 0; pp < 6; ++pp) wf[0][pp] = *(const LAS bf16x8*)(WB + fr * RS + (8 * fq) * 2 + ((pp >> 1) * 32 + (pp & 1) * 16) * RS);
#pragma unroll
                for (int j = 0; j < 8; ++j) {
                    const v4u xw = xc[j]; const bf16x8 xa8 = __builtin_bit_cast(bf16x8, xw);
                    if (j + 1 < 8) {
#pragma unroll
                        for (int pp = 0; pp < 6; ++pp) wf[(j + 1) & 1][pp] = *(const LAS bf16x8*)(WB + fr * RS + (32 * (j + 1) + 8 * fq) * 2 + ((pp >> 1) * 32 + (pp & 1) * 16) * RS);
                    }
                    asm volatile("" ::: "memory");
#pragma unroll
                    for (int part = 2; part >= 0; --part) {
                        acc0 = __builtin_amdgcn_mfma_f32_16x16x32_bf16(xa8, wf[j & 1][2 * part], acc0, 0, 0, 0);
                        acc1 = __builtin_amdgcn_mfma_f32_16x16x32_bf16(xa8, wf[j & 1][2 * part + 1], acc1, 0, 0, 0); }
                    const float xa[8] = {bflo(xw.x), bfhi(xw.x), bflo(xw.y), bfhi(xw.y), bflo(xw.z), bfhi(xw.z), bflo(xw.w), bfhi(xw.w)};
#pragma unroll
                    for (int s8 = 0; s8 < 8; ++s8) ssq += xa[s8] * xa[s8];
                    v2u hw; hw.x = pk4_fp8(xa[0], xa[1], xa[2], xa[3]); hw.y = pk4_fp8(xa[4], xa[5], xa[6], xa[7]); hp8[4 * (8 * c + j)] = hw;
                }
                if (c + 1 < 8) {
#pragma unroll
                    for (int i = 0; i < 6; ++i) { const int p = tid + 512 * i; *(LAS v4u*)(lds + ((c + 1) & 1) * WBUF + (p >> 5) * RS + (p & 31) * 16) = wst[i]; }
#pragma unroll
                    for (int j = 0; j < 8; ++j) xc[j] = xn[j];
                    asm volatile("s_waitcnt lgkmcnt(0)" ::: "memory"); __builtin_amdgcn_s_barrier(); asm volatile("" ::: "memory");
                }
            }
            ssq += __shfl_xor(ssq, 16); ssq += __shfl_xor(ssq, 32);
            const float rstd = 1.0f / sqrtf(ssq * (1.f / D) + NORM_EPS);
            if (fq == 0) rstd_tok[tok0 + fr] = rstd;
#pragma unroll
            for (int rg = 0; rg < 4; ++rg) {
                const float rs = __shfl(rstd, 4 * fq + rg);
                float v0 = acc0[rg] * rs + br0, v1 = acc1[rg] * rs + br1;
                int ti[4]; float tv[4];
#pragma unroll
                for (int r = 0; r < 4; ++r) {
                    float m = fmaxf(v0, v1); m = fmaxf(m, dpp_xor1(m)); m = fmaxf(m, dpp_xor2(m)); m = fmaxf(m, dpp_hmir(m)); m = fmaxf(m, dpp_rmir(m));
                    const int cand = (v0 == m) ? fr : ((v1 == m) ? 16 + fr : 99);
                    float cf = (float)cand; cf = fminf(cf, dpp_xor1(cf)); cf = fminf(cf, dpp_xor2(cf)); cf = fminf(cf, dpp_hmir(cf)); cf = fminf(cf, dpp_rmir(cf));
                    const int idx = (int)cf; ti[r] = idx; tv[r] = m;
                    if (idx == fr) v0 = -3.0e38f;
                    if (idx == 16 + fr) v1 = -3.0e38f;
                }
                const float e1 = __expf(tv[1] - tv[0]), e2 = __expf(tv[2] - tv[0]), e3 = __expf(tv[3] - tv[0]);
                const float inv = 1.0f / (1.0f + e1 + e2 + e3);
                const size_t tok = tok0 + 4 * fq + rg;
                if (fr == 0) { *(int4*)(topi + tok * 4) = make_int4(ti[0], ti[1], ti[2], ti[3]); *(f32x4*)(topg + tok * 4) = (f32x4){inv, e1 * inv, e2 * inv, e3 * inv}; }
                if (fr < 4) { const int ee = fr == 0 ? ti[0] : (fr == 1 ? ti[1] : (fr == 2 ? ti[2] : ti[3])); atomicAdd((unsigned*)&lcnt[ee & 31], 1u); }
            }
        }
        __syncthreads();
        if (tid < 32 && lcnt[tid] > 0u) __hip_atomic_fetch_add(cntw + tid, lcnt[tid], RLX_AGENT);
        if (BOTH(9)) GRID_BAR();
    }
    if (IN(10)) {
        LAS unsigned* lcnt = (LAS unsigned*)(lds);
        LAS unsigned* lbase = (LAS unsigned*)(lds + 256);
        LAS unsigned* lpos = (LAS unsigned*)(lds + 512);
        if (tid < 32) { lcnt[tid] = 0u; lpos[tid] = 0u; }
        __syncthreads();
        const int tpb = NT / G;
        const int tbeg = bx * tpb;
        for (int i = tid; i < tpb * 4; i += 512) { const int ee = topi[(size_t)tbeg * 4 + i]; atomicAdd((unsigned*)&lcnt[ee], 1u); }
        __syncthreads();
        if (tid < 64) {
            const unsigned tiles = (tid < 32) ? (__hip_atomic_load(cntw + (tid & 31), RLX_AGENT) + 255u) / 256u : 0u;
            unsigned incl = tiles;
#pragma unroll
            for (int o = 1; o < 32; o <<= 1) { const unsigned t_ = __shfl_up(incl, o); if ((tid & 63) >= o) incl += t_; }
            if (tid < 32) {
                const unsigned tbase = incl - tiles;
                const unsigned r0 = lcnt[tid] ? __hip_atomic_fetch_add(ctl + CW_CUR + tid, lcnt[tid], RLX_AGENT) : 0u;
                lbase[tid] = tbase * 256u + r0; }
        }
        __syncthreads();
        for (int i = tid; i < tpb * 4; i += 512) { const int ee = topi[(size_t)tbeg * 4 + i];
            const unsigned p = atomicAdd((unsigned*)&lpos[ee], 1u); const unsigned slot = lbase[ee] + p;
            tokslot[slot] = tbeg + (i >> 2); slotof[(size_t)tbeg * 4 + i] = (int)slot; rss[slot] = rstd_tok[tbeg + (i >> 2)]; }
        if (BOTH(10)) GRID_BAR();
    }
    if (IN(11) || IN(12)) {
        __syncthreads();
        if (tid < 64) {
            const int n = (tid < 32) ? (int)((__hip_atomic_load(cntw + (tid & 31), RLX_AGENT) + 255u) / 256u) : 0;
            int incl = n;
#pragma unroll
            for (int o = 1; o < 32; o <<= 1) { const int t_ = __shfl_up(incl, o); if ((tid & 63) >= o) incl += t_; }
            const int start = incl - n;
            if (tid < 32) for (int j = 0; j < n && start + j < MAX_TILES; ++j) TAB[start + j] = tid;
            if (tid == 31) TAB[MAX_TILES] = incl < MAX_TILES ? incl : MAX_TILES; }
        __syncthreads();
    }
    if (IN(11)) {
        ProbMoe1 P; P.K = 2048; P.S.tile_e = TAB; P.S.ntiles = __builtin_amdgcn_readfirstlane(TAB[MAX_TILES]); P.S.G = G; P.S.c = bx;
        P.H2 = H8; P.W1t = W1T; P.b1 = args.in[I_B1]; P.tokslot = tokslot; P.ACT = ACT; P.rss = rss;
        pg8::gemm_phase(lds, P);
        if (BOTH(11)) GRID_BAR();
    }
    if (IN(12)) {
        ProbMoe2 P; P.K = 2048; P.S.tile_e = TAB; P.S.ntiles = __builtin_amdgcn_readfirstlane(TAB[MAX_TILES]); P.S.G = G; P.S.c = bx;
        P.ACT = ACT; P.W2t = W2T; P.b2 = args.in[I_B2]; P.Y = Yb;
        pg8::gemm_phase(lds, P);
        if (BOTH(12)) GRID_BAR();
    }
    if (IN(13)) {
        const float* gf = args.in[I_NFG];
        int4 sl_n = make_int4(0, 0, 0, 0); f32x4 gt_n = (f32x4){0.f, 0.f, 0.f, 0.f};
        if (gw < NT) { sl_n = *(const int4*)(slotof + (size_t)gw * 4); gt_n = *(const f32x4*)(topg + (size_t)gw * 4); }
        for (int tok = gw; tok < NT; tok += NGW) {
            const v2u* xr = (const v2u*)(X1 + (size_t)tok * D) + lane;
            const int4 sl = sl_n; const f32x4 gt = gt_n;
            if (tok + NGW < NT) { sl_n = *(const int4*)(slotof + (size_t)(tok + NGW) * 4); gt_n = *(const f32x4*)(topg + (size_t)(tok + NGW) * 4); }
            const unsigned* y0 = (const unsigned*)(Yb + (size_t)sl.x * D) + lane; const unsigned* y1 = (const unsigned*)(Yb + (size_t)sl.y * D) + lane;
            const unsigned* y2 = (const unsigned*)(Yb + (size_t)sl.z * D) + lane; const unsigned* y3 = (const unsigned*)(Yb + (size_t)sl.w * D) + lane;
            f32x4 v[8]; float s = 0.f;
#pragma unroll
            for (int j = 0; j < 8; ++j) { { const v2u xw = xr[64 * j]; v[j] = (f32x4){bflo(xw.x), bfhi(xw.x), bflo(xw.y), bfhi(xw.y)}; } const unsigned a = y0[64 * j], b = y1[64 * j], c = y2[64 * j], d = y3[64 * j];
                const f32x2 a0 = __builtin_amdgcn_cvt_pk_f32_fp8(a, false), a1 = __builtin_amdgcn_cvt_pk_f32_fp8(a, true), b0 = __builtin_amdgcn_cvt_pk_f32_fp8(b, false), b1 = __builtin_amdgcn_cvt_pk_f32_fp8(b, true);
                const f32x2 c0 = __builtin_amdgcn_cvt_pk_f32_fp8(c, false), c1 = __builtin_amdgcn_cvt_pk_f32_fp8(c, true), d0 = __builtin_amdgcn_cvt_pk_f32_fp8(d, false), d1 = __builtin_amdgcn_cvt_pk_f32_fp8(d, true);
                v[j].x += gt.x * a0[0] + gt.y * b0[0] + gt.z * c0[0] + gt.w * d0[0];
                v[j].y += gt.x * a0[1] + gt.y * b0[1] + gt.z * c0[1] + gt.w * d0[1];
                v[j].z += gt.x * a1[0] + gt.y * b1[0] + gt.z * c1[0] + gt.w * d1[0];
                v[j].w += gt.x * a1[1] + gt.y * b1[1] + gt.z * c1[1] + gt.w * d1[1];
                s += (v[j].x * v[j].x + v[j].y * v[j].y) + (v[j].z * v[j].z + v[j].w * v[j].w); }
            const float rstd = 1.0f / sqrtf(wave_sum(s) * (1.f / D) + NORM_EPS);
            f32x4* op = (f32x4*)(args.out + (size_t)tok * D) + lane; const f32x4* gr = (const f32x4*)gf + lane;
#pragma unroll
            for (int j = 0; j < 8; ++j) { const f32x4 gg = gr[64 * j]; op[64 * j] = (f32x4){v[j].x * rstd * gg.x, v[j].y * rstd * gg.y, v[j].z * rstd * gg.z, v[j].w * rstd * gg.w}; }
        }
    }
#undef IN
#undef BOTH
}

extern "C" void kernel_launch(void* const* d_in, const int* in_sizes, int n_in, void* d_out, int out_size, void* d_ws, size_t ws_size, hipStream_t stream) {
    static int grid = 0;
    if (grid == 0) {
        if (n_in != 27 || out_size != NT * D || ws_size < WS_END) { fprintf(stderr, "kernel_launch: unexpected shapes (n_in %d out %d ws %zu)\n", n_in, out_size, ws_size); grid = -1; return; }
        int dev = 0, cus = 0;
        if (hipGetDevice(&dev) != hipSuccess || hipDeviceGetAttribute(&cus, hipDeviceAttributeMultiprocessorCount, dev) != hipSuccess) { grid = -1; return; }
        if (hipFuncSetAttribute((const void*)fwd, hipFuncAttributeMaxDynamicSharedMemorySize, LDS_BYTES) != hipSuccess) { fprintf(stderr, "kernel_launch: hipFuncSetAttribute failed\n"); grid = -1; return; }
        int per_cu = 0;
        if (hipOccupancyMaxActiveBlocksPerMultiprocessor(&per_cu, (const void*)fwd, 512, LDS_BYTES) != hipSuccess || per_cu < 1) fprintf(stderr, "kernel_launch: occupancy query reports %d\n", per_cu);
        (void)hipGetLastError();
        grid = cus;
    }
    if (grid < 0) return;
    (void)hipMemsetAsync((char*)d_ws + WS_CTL, 0, CTL_ZERO_BYTES, stream);
    Args a{};
    for (int i = 0; i < 27; ++i) a.in[i] = (const float*)d_in[i];
    a.out = (float*)d_out; a.ws = (unsigned char*)d_ws;
#if MK_N_LAUNCHES == 1
#if defined(PROBE_LO)
    a.ph_lo = 0; a.ph_hi = PROBE_HI; a.li = 0;
    hipLaunchKernelGGL(fwd, dim3(grid), dim3(512), LDS_BYTES, stream, a);
    a.ph_lo = PROBE_LO; a.ph_hi = NPHASE; a.li = 1;
    hipLaunchKernelGGL(fwd, dim3(grid), dim3(512), LDS_BYTES, stream, a);
#else
    a.ph_lo = 0; a.ph_hi = NPHASE; a.li = 0;
    hipLaunchKernelGGL(fwd, dim3(grid), dim3(512), LDS_BYTES, stream, a);
#endif
#else
    for (int p = 0; p < NPHASE; ++p) { a.ph_lo = p; a.ph_hi = p + 1; a.li = p; hipLaunchKernelGGL(fwd, dim3(grid), dim3(512), LDS_BYTES, stream, a); }
#endif
}
```
